# Optimizing an MI355X kernel written in HIP

```python
import jax, jax.numpy as jnp
from jax import lax
import numpy as np

D_MODEL = 1024
BATCH = 2
SEQ = 8192
DEPTH = 4

GRID_W = 64
CTX_LEN = 256
D_A = 1024
CONV_W = 3
B_HEADS = 16
B_HEAD = 64
D_B = B_HEADS * B_HEAD
R_W = 64
R_A = 64
R_G = 128
GN_EPS = 64e-5
C_HEADS = 16
C_KV = 4
C_GROUP = C_HEADS // C_KV
HEAD_DIM = 64
WINDOW = 128
ATT_BLOCK = 128
ATT_SCALE = HEAD_DIM ** -0.5
ROPE_THETA = 10000.0
NEG_INF = -1e30
D_FF = 2816
NORM_EPS = 1e-6
N_BRANCH = 3
IN_SPLITS = (D_A, D_A, D_A, 3 * D_B, 2 * R_W, 2 * R_A, R_G,
             C_HEADS * HEAD_DIM, C_KV * HEAD_DIM, C_KV * HEAD_DIM, N_BRANCH * D_MODEL)
N_IN = sum(IN_SPLITS)

kernel_name = "hybrid_conv_rwkv7_swa_diffusion_trunk"


def rmsnorm(x, g):
    xf = x.astype(jnp.float32)
    y = xf * lax.rsqrt(jnp.mean(xf * xf, axis=-1, keepdims=True) + NORM_EPS)
    return (y * g.astype(jnp.float32)).astype(x.dtype)


def modulate(x, g, shift, scale):
    return rmsnorm(x, g) * (1.0 + scale) + shift


def dwconv3(x, w):
    xp = jnp.pad(x, ((0, 0), (1, 1), (0, 0)))
    return xp[:, :-2] * w[0] + xp[:, 1:-1] * w[1] + xp[:, 2:] * w[2]


def split_cols(p):
    offsets = tuple(int(o) for o in np.cumsum(IN_SPLITS)[:-1])
    return jnp.split(p, offsets, axis=-1)


def axial_rope_tables(seq, dtype):
    rows = seq // GRID_W
    t_row = jnp.broadcast_to(jnp.arange(rows)[:, None], (rows, GRID_W)).reshape(-1).astype(jnp.float32)
    t_col = jnp.broadcast_to(jnp.arange(GRID_W)[None, :], (rows, GRID_W)).reshape(-1).astype(jnp.float32)
    n_freq = HEAD_DIM // 4
    inv = ROPE_THETA ** (-jnp.arange(n_freq, dtype=jnp.float32) / n_freq)
    ang = jnp.stack([t_row[:, None] * inv, t_col[:, None] * inv], axis=1)
    return jnp.cos(ang).astype(dtype), jnp.sin(ang).astype(dtype)


def apply_rope2d(x, cos, sin):
    shp = x.shape
    xr = x.reshape(shp[:-1] + (2, 2, HEAD_DIM // 4))
    x1, x2 = xr[..., 0, :], xr[..., 1, :]
    c, s = cos[:, None], sin[:, None]
    out = jnp.stack([x1 * c - x2 * s, x1 * s + x2 * c], axis=-2)
    return out.reshape(shp)


def windowed_attention(q, k, v, kc, vc, sink):
    b, s = q.shape[:2]
    nb = s // ATT_BLOCK
    qb = q.reshape(b, nb, ATT_BLOCK, C_KV, C_GROUP, HEAD_DIM)

    def band(t):
        tp = jnp.pad(t, ((0, 0), (ATT_BLOCK, ATT_BLOCK), (0, 0), (0, 0)))
        tp = tp.reshape(b, nb + 2, ATT_BLOCK, C_KV, HEAD_DIM)
        return jnp.concatenate([tp[:, :-2], tp[:, 1:-1], tp[:, 2:]], axis=2)

    kb, vb = band(k), band(v)
    s_loc = jnp.einsum('bnqkgd,bnskd->bnkgqs', qb, kb).astype(jnp.float32)
    s_ctx = jnp.einsum('bnqkgd,bckd->bnkgqc', qb, kc).astype(jnp.float32)
    qi = jnp.arange(ATT_BLOCK)
    si = jnp.arange(3 * ATT_BLOCK)
    rel = si[None, :] - ATT_BLOCK - qi[:, None]
    kpos = jnp.arange(nb)[:, None, None] * ATT_BLOCK + si[None, None, :] - ATT_BLOCK
    mask = (jnp.abs(rel) <= WINDOW)[None] & (kpos >= 0) & (kpos < s)
    s_loc = jnp.where(mask[None, :, None, None], s_loc, NEG_INF)
    sink_b = jnp.broadcast_to(sink.reshape(C_KV, C_GROUP, 1, 1).astype(jnp.float32), s_ctx.shape[:-1] + (1,))
    probs = jax.nn.softmax(jnp.concatenate([s_loc, s_ctx, sink_b], axis=-1), axis=-1).astype(v.dtype)
    n_loc, n_ctx = 3 * ATT_BLOCK, kc.shape[1]
    o = (jnp.einsum('bnkgqs,bnskd->bnqkgd', probs[..., :n_loc], vb)
         + jnp.einsum('bnkgqc,bckd->bnqkgd', probs[..., n_loc:n_loc + n_ctx], vc))
    return o.reshape(b, s, C_HEADS * HEAD_DIM)


def context_attention(qc, kc, vc, sink):
    b, c = qc.shape[:2]
    qg = qc.reshape(b, c, C_KV, C_GROUP, HEAD_DIM)
    sc = jnp.einsum('bqkgd,bskd->bkgqs', qg, kc).astype(jnp.float32)
    sink_b = jnp.broadcast_to(sink.reshape(C_KV, C_GROUP, 1, 1).astype(jnp.float32), sc.shape[:-1] + (1,))
    probs = jax.nn.softmax(jnp.concatenate([sc, sink_b], axis=-1), axis=-1).astype(vc.dtype)
    o = jnp.einsum('bkgqs,bskd->bqkgd', probs[..., :c], vc)
    return o.reshape(b, c, C_HEADS * HEAD_DIM)


def rwkv_inputs(rkv, wl, al, gl, p):
    b, t = rkv.shape[:2]
    f = jnp.float32
    mu = p['rwkv_mu']
    shift_w = jnp.stack([mu[0], 1.0 - mu[0] - mu[1], mu[1]])
    r, k, v = jnp.split(dwconv3(rkv, shift_w), 3, axis=-1)
    wl = wl.reshape(b, t, 2, R_W)
    al = al.reshape(b, t, 2, R_A)
    w_pre = p['rwkv_w0'] + jnp.einsum('btdr,drc->btdc', jnp.tanh(wl), p['rwkv_w2'])
    w_log = -jax.nn.softplus(-w_pre.astype(f)) - 0.5
    decay = jnp.exp(-jnp.exp(w_log))
    a = jax.nn.sigmoid((p['rwkv_a0'] + jnp.einsum('btdr,drc->btdc', al, p['rwkv_a2'])).astype(f))
    g = jax.nn.sigmoid(gl) @ p['rwkv_g2']

    def heads(z):
        return z.reshape(z.shape[:-1] + (B_HEADS, B_HEAD))

    kk = heads((k * p['rwkv_k_k']).astype(f))
    kk = kk * lax.rsqrt(jnp.sum(kk * kk, axis=-1, keepdims=True) + 1e-12)
    k_d = heads(k.astype(f)[:, :, None] * (1.0 + (a - 1.0) * p['rwkv_k_a'].astype(f)))
    b_d = kk[:, :, None] * heads(a)
    return heads(r.astype(f)), heads(v.astype(f)), kk, heads(decay), k_d, b_d, g


def rwkv_scan(s0, r, v, kk, decay, k_d, b_d, emit):
    b, t = r.shape[:2]

    def both(z):
        return jnp.broadcast_to(z[:, :, None], (b, t, 2) + z.shape[2:])

    def to_dirs(z):
        return jnp.stack([z[:, :, 0], jnp.flip(z[:, :, 1], axis=1)], axis=0).transpose(2, 0, 1, 3, 4)

    xs = tuple(to_dirs(z) for z in (both(r), decay, k_d, both(v), both(-kk), b_d))

    def step(S, inp):
        rt, wt, kt, vt, at, bt = inp
        sa = jnp.einsum('dbhvk,dbhk->dbhv', S, at)
        S = S * wt[..., None, :] + sa[..., :, None] * bt[..., None, :] + vt[..., :, None] * kt[..., None, :]
        y = jnp.einsum('dbhvk,dbhk->dbhv', S, rt) if emit else None
        return S, y

    s_fin, ys = lax.scan(step, s0, xs)
    if not emit:
        return s_fin, None
    y = ys[:, 0] + jnp.flip(ys[:, 1], axis=0)
    return s_fin, y.transpose(1, 0, 2, 3)


def rwkv_branch(y, r, v, k_d, g, p, dtype):
    b, t = y.shape[:2]
    mean = jnp.mean(y, axis=-1, keepdims=True)
    var = jnp.mean(jnp.square(y - mean), axis=-1, keepdims=True)
    gn = ((y - mean) * lax.rsqrt(var + GN_EPS)).reshape(b, t, D_B) * p['rwkv_ln_g'] + p['rwkv_ln_b']
    bonus = jnp.sum(jnp.sum(r[:, :, None] * k_d * p['rwkv_r_k'], axis=-1, keepdims=True) * v[:, :, None], axis=2)
    return ((gn + bonus.reshape(b, t, D_B)) * g).astype(dtype)


def short_conv(bg, cg, xin, conv_w):
    return bg * dwconv3(cg * xin, conv_w)


def merge_branches(ya, yb, yc, gates, p):
    ga, gb, gc = jnp.split(jax.nn.sigmoid(gates), N_BRANCH, axis=-1)
    m = ga * (ya @ p['a_out_w']) + gb * (yb @ p['rwkv_out_w']) + gc * (yc @ p['attn_out_w'])
    return m @ p['w_o']


def conv_ffn(h, p):
    u = dwconv3(h @ p['ffn_up'], p['ffn_conv'])
    ug, uv = jnp.split(u, 2, axis=-1)
    return (jax.nn.silu(ug) * uv) @ p['ffn_down']


def trunk_layer(xc, xl, c, c_ctx, cos, sin, p, ctx_out):
    b = xl.shape[0]
    dt = xl.dtype
    mod_l = jnp.split((jax.nn.silu(c) @ p['ada_w'] + p['ada_b'])[:, None, :], 6, axis=-1)
    mod_c = jnp.split(jax.nn.silu(c_ctx) @ p['ada_w'] + p['ada_b'], 6, axis=-1)
    hl = modulate(xl, p['norm1_g'], mod_l[0], mod_l[1])
    hc = modulate(xc, p['norm1_g'], mod_c[0], mod_c[1])
    (ab_l, ac_l, ax_l, rkv_l, wl_l, al_l, gl_l, q_l, k_l, v_l, gate_l) = split_cols(hl @ p['w_in'])
    (ab_c, ac_c, ax_c, rkv_c, wl_c, al_c, gl_c, q_c, k_c, v_c, gate_c) = split_cols(hc @ p['w_in'])

    def heads_q(z):
        return z.reshape(z.shape[:2] + (C_HEADS, HEAD_DIM))

    def heads_kv(z):
        return z.reshape(z.shape[:2] + (C_KV, HEAD_DIM))

    kc, vc = heads_kv(k_c), heads_kv(v_c)
    ql = apply_rope2d(heads_q(q_l), cos, sin) * ATT_SCALE
    kl = apply_rope2d(heads_kv(k_l), cos, sin)
    att_l = windowed_attention(ql, kl, heads_kv(v_l), kc, vc, p['attn_sink'])

    r_c, vr_c, kk_c, dec_c, kd_c, bd_c, g_c = rwkv_inputs(rkv_c, wl_c, al_c, gl_c, p)
    s0 = jnp.zeros((2, b, B_HEADS, B_HEAD, B_HEAD), jnp.float32)
    s_ctx, y_rc = rwkv_scan(s0, r_c, vr_c, kk_c, dec_c, kd_c, bd_c, ctx_out)
    r_l, vr_l, kk_l, dec_l, kd_l, bd_l, g_l = rwkv_inputs(rkv_l, wl_l, al_l, gl_l, p)
    _, y_rl = rwkv_scan(s_ctx, r_l, vr_l, kk_l, dec_l, kd_l, bd_l, True)
    rwkv_l = rwkv_branch(y_rl, r_l, vr_l, kd_l, g_l, p, dt)

    conv_l = short_conv(ab_l, ac_l, ax_l, p['conv_a_w'])

    xl = xl + mod_l[2] * merge_branches(conv_l, rwkv_l, att_l, gate_l, p)
    xl = xl + mod_l[5] * conv_ffn(modulate(xl, p['norm2_g'], mod_l[3], mod_l[4]), p)

    if ctx_out:
        att_c = context_attention(heads_q(q_c) * ATT_SCALE, kc, vc, p['attn_sink'])
        rwkv_c = rwkv_branch(y_rc, r_c, vr_c, kd_c, g_c, p, dt)
        conv_c = short_conv(ab_c, ac_c, ax_c, p['conv_a_w'])
        xc = xc + mod_c[2] * merge_branches(conv_c, rwkv_c, att_c, gate_c, p)
        xc = xc + mod_c[5] * conv_ffn(modulate(xc, p['norm2_g'], mod_c[3], mod_c[4]), p)
    else:
        xc = None
    return xc, xl


def setup_inputs(seed: int = 0) -> dict:
    key = jax.random.key(seed)
    ks = iter(jax.random.split(key, 40))
    f = jnp.float32
    L = DEPTH

    def nrm(shape, scale):
        return jax.random.normal(next(ks), shape, f) * scale

    def gain(shape):
        return 1.0 + nrm(shape, 0.05)

    return {
        'x': nrm((BATCH, SEQ, D_MODEL), 1.0),
        'c': nrm((BATCH, D_MODEL), 1.0),
        'ctx': nrm((BATCH, CTX_LEN, D_MODEL), 1.0),
        'c_ctx': nrm((D_MODEL,), 1.0),
        'ada_w': nrm((L, D_MODEL, 6 * D_MODEL), 0.5 * D_MODEL ** -0.5),
        'ada_b': nrm((L, 6 * D_MODEL), 0.02),
        'norm1_g': gain((L, D_MODEL)),
        'w_in': nrm((L, D_MODEL, N_IN), D_MODEL ** -0.5),
        'conv_a_w': nrm((L, CONV_W, D_A), CONV_W ** -0.5),
        'a_out_w': nrm((L, D_A, D_MODEL), D_A ** -0.5),
        'rwkv_mu': jax.random.uniform(next(ks), (L, 2, 3 * D_B), f, 0.0, 0.4),
        'rwkv_w0': jax.random.uniform(next(ks), (L, 2, D_B), f, -6.0, -1.0),
        'rwkv_w2': nrm((L, 2, R_W, D_B), 0.5 * R_W ** -0.5),
        'rwkv_a0': nrm((L, 2, D_B), 0.1),
        'rwkv_a2': nrm((L, 2, R_A, D_B), R_A ** -0.5),
        'rwkv_g2': nrm((L, R_G, D_B), R_G ** -0.5),
        'rwkv_k_k': 0.85 + nrm((L, D_B), 0.05),
        'rwkv_k_a': gain((L, D_B)),
        'rwkv_r_k': nrm((L, B_HEADS, B_HEAD), 0.1),
        'rwkv_ln_g': gain((L, D_B)),
        'rwkv_ln_b': nrm((L, D_B), 0.02),
        'rwkv_out_w': nrm((L, D_B, D_MODEL), D_B ** -0.5),
        'attn_sink': nrm((L, C_HEADS), 0.5),
        'attn_out_w': nrm((L, C_HEADS * HEAD_DIM, D_MODEL), (C_HEADS * HEAD_DIM) ** -0.5),
        'w_o': nrm((L, D_MODEL, D_MODEL), D_MODEL ** -0.5),
        'norm2_g': gain((L, D_MODEL)),
        'ffn_up': nrm((L, D_MODEL, 2 * D_FF), D_MODEL ** -0.5),
        'ffn_conv': nrm((L, CONV_W, 2 * D_FF), CONV_W ** -0.5),
        'ffn_down': nrm((L, D_FF, D_MODEL), D_FF ** -0.5),
        'final_norm_g': gain((D_MODEL,)),
    }


def reference(x, c, ctx, c_ctx, ada_w, ada_b, norm1_g, w_in, conv_a_w, a_out_w, rwkv_mu, rwkv_w0, rwkv_w2,
              rwkv_a0, rwkv_a2, rwkv_g2, rwkv_k_k, rwkv_k_a, rwkv_r_k, rwkv_ln_g, rwkv_ln_b, rwkv_out_w,
              attn_sink, attn_out_w, w_o, norm2_g, ffn_up, ffn_conv, ffn_down, final_norm_g):
    cos, sin = axial_rope_tables(x.shape[1], x.dtype)
    xl, xc = x, ctx
    for i in range(DEPTH):
        p = dict(ada_w=ada_w[i], ada_b=ada_b[i], norm1_g=norm1_g[i], w_in=w_in[i], conv_a_w=conv_a_w[i],
                 a_out_w=a_out_w[i], rwkv_mu=rwkv_mu[i], rwkv_w0=rwkv_w0[i], rwkv_w2=rwkv_w2[i],
                 rwkv_a0=rwkv_a0[i], rwkv_a2=rwkv_a2[i], rwkv_g2=rwkv_g2[i], rwkv_k_k=rwkv_k_k[i],
                 rwkv_k_a=rwkv_k_a[i], rwkv_r_k=rwkv_r_k[i], rwkv_ln_g=rwkv_ln_g[i], rwkv_ln_b=rwkv_ln_b[i],
                 rwkv_out_w=rwkv_out_w[i], attn_sink=attn_sink[i], attn_out_w=attn_out_w[i], w_o=w_o[i],
                 norm2_g=norm2_g[i], ffn_up=ffn_up[i], ffn_conv=ffn_conv[i], ffn_down=ffn_down[i])
        xc, xl = trunk_layer(xc, xl, c, c_ctx, cos, sin, p, i < DEPTH - 1)
    return rmsnorm(xl, final_norm_g)
```

```cpp
#include <hip/hip_runtime.h>
#include <hip/hip_cooperative_groups.h>
#include <cstdio>
namespace cg = cooperative_groups;

#define LAS __attribute__((address_space(3)))
#define DI __device__ __forceinline__
typedef unsigned short bf16_t;
typedef short bf16x8 __attribute__((ext_vector_type(8)));
typedef short s16x4 __attribute__((ext_vector_type(4)));
typedef float f32x2 __attribute__((ext_vector_type(2)));
typedef float f32x4 __attribute__((ext_vector_type(4)));
typedef float f32x16 __attribute__((ext_vector_type(16)));
typedef unsigned u32x2 __attribute__((ext_vector_type(2)));
typedef unsigned u32x4 __attribute__((ext_vector_type(4)));
typedef __bf16 bf16x2_t __attribute__((ext_vector_type(2)));

constexpr int DM = 1024, NB = 2, SEQ = 8192, DEPTH = 4, CTXL = 256;
constexpr int NTL = NB * SEQ;
constexpr int NTC = NB * CTXL;
constexpr int NTOK = NTL + NTC;
constexpr int NIN = 11136, DFF = 2816;
constexpr int NTHR = 512;
constexpr int LDS_BYTES = 131072;

constexpr size_t AL(size_t x) { return (x + 255) & ~(size_t)255; }
constexpr size_t SZ16 = (size_t)NTOK * 1024 * 2;
constexpr size_t WS_MOD   = 0;
constexpr size_t WS_ROPE  = WS_MOD + AL((size_t)DEPTH * 3 * 6144 * 4);
constexpr size_t WS_XC    = WS_ROPE + AL(128 * 16 * 2 * 4);
constexpr size_t WS_WIN   = WS_XC + AL((size_t)NTC * 1024 * 4);
constexpr size_t WS_WV    = WS_WIN + AL((size_t)11008 * 1024 * 2);
constexpr size_t WS_WLORA = WS_WV + AL((size_t)256 * 1024 * 2);
constexpr size_t WS_WA    = WS_WLORA + AL((size_t)5120 * 384 * 2);
constexpr size_t WS_WUP   = WS_WA + 4 * AL((size_t)1024 * 1024 * 2);
constexpr size_t WS_WDN   = WS_WUP + AL((size_t)5632 * 1024 * 2);
constexpr size_t WS_H     = WS_WDN + AL((size_t)1024 * 2816 * 2);
constexpr size_t WS_AB    = WS_H + SZ16;
constexpr size_t WS_AC    = WS_AB + SZ16;
constexpr size_t WS_AX    = WS_AC + SZ16;
constexpr size_t WS_RKV   = WS_AX + SZ16;
constexpr size_t WS_LACT  = WS_RKV + 3 * SZ16;
constexpr size_t WS_Q     = WS_LACT + SZ16 / 2;
constexpr size_t WS_K     = WS_Q + SZ16;
constexpr size_t WS_VT    = WS_K + SZ16 / 4;
constexpr size_t WS_GATES = WS_VT + SZ16 / 4;
constexpr size_t WS_LOUT  = WS_GATES + 3 * SZ16;
constexpr size_t WS_YB2   = WS_LOUT + 5 * SZ16;
constexpr size_t WS_END   = WS_YB2 + SZ16;
constexpr size_t WS_U     = WS_AB;
static_assert((size_t)NTOK * 5632 * 2 <= 6 * SZ16, "u alias");
static_assert(WS_END <= (size_t)729 * 1000 * 1000, "workspace");

struct Params {
  const float* in[30];
  float* out;
  unsigned char* ws;
};

typedef const __attribute__((address_space(4))) Params* PP;
DI float bf2f(unsigned v) { return __uint_as_float(v << 16); }
DI float bflo(unsigned v) { return __uint_as_float(v << 16); }
DI float bfhi(unsigned v) { return __uint_as_float(v & 0xffff0000u); }
DI unsigned pk2(float a, float b) { f32x2 v = {a, b}; bf16x2_t r = __builtin_convertvector(v, bf16x2_t); return __builtin_bit_cast(unsigned, r); }
DI float sigmoidf_(float x) { return __builtin_amdgcn_rcpf(1.0f + __builtin_amdgcn_exp2f(-1.4426950408889634f * x)); }
DI float wave_sum(float v) {
#pragma unroll
  for (int o = 32; o >= 1; o >>= 1) v += __shfl_xor(v, o);
  return v;
}
DI float ar16(float x) {
  x += __builtin_bit_cast(float, __builtin_amdgcn_update_dpp(0, __builtin_bit_cast(int, x), 0x128, 0xf, 0xf, false));
  x += __builtin_bit_cast(float, __builtin_amdgcn_update_dpp(0, __builtin_bit_cast(int, x), 0x124, 0xf, 0xf, false));
  x += __builtin_bit_cast(float, __builtin_amdgcn_update_dpp(0, __builtin_bit_cast(int, x), 0x122, 0xf, 0xf, false));
  x += __builtin_bit_cast(float, __builtin_amdgcn_update_dpp(0, __builtin_bit_cast(int, x), 0x121, 0xf, 0xf, false));
  return x;
}
namespace pg8 {
constexpr int BM = 256, BK = 64, HALF = 128, HTB = HALF * BK * 2, NXCD = 8, WGM = 8;
DI int lds_byte(int r, int c) { const int st = (r >> 4) * 2 + (c >> 5), rr = r & 15, cc = c & 31, ob = rr * 64 + cc * 2; return st * 1024 + (ob ^ (((ob >> 9) & 1) << 5)); }
DI void stage_rc(int b, int& R, int& C) { const int st = b / 1024, sb = b % 1024, swz = sb ^ (((sb >> 9) & 1) << 5); R = (st >> 1) * 16 + swz / 64; C = (st & 1) * 32 + (swz % 64) / 2; }
DI int perm32(int rho) { const int n = rho >> 4, i = rho & 15; return 8 * (i >> 2) + 4 * n + (i & 3); }
struct Unit { int pm, pn; };
struct Gemm { const bf16_t* A; const bf16_t* Bt; int M, N, K, lda, ldb; };
struct StaticOrder {
  int nM, nN, nwg, G, c;
  DI void init(int M, int N, int G_, int c_) { nM = M / BM; nN = N / BM; nwg = nM * nN; G = G_; c = c_; }
  DI bool next(int i, Unit& u) const {
    const long L = (long)i * G + c; if (L >= nwg) return false;
    int wgid = (int)L; { const int q = nwg / NXCD, r = nwg % NXCD, xcd = wgid % NXCD, off = wgid / NXCD; wgid = (xcd < r ? xcd * (q + 1) : r * (q + 1) + (xcd - r) * q) + off; }
    const int nig = WGM * nN, gid = wgid / nig, fm = gid * WGM, gsz = (nM - fm) < WGM ? (nM - fm) : WGM;
    u.pm = fm + ((wgid % nig) % gsz); u.pn = (wgid % nig) / gsz; return true;
  }
};

template <class Epi>
DI void gemm_phase(LAS unsigned char* lds, const Gemm g, const StaticOrder& S, const Epi& E) {
  int tid = threadIdx.x; asm volatile("" : "+v"(tid));
  const int wid = __builtin_amdgcn_readfirstlane(tid >> 6), lane = tid & 63, wr = wid >> 2, wc = wid & 3, fr = lane & 15, fq = lane >> 4;
  const int K = g.K, nt = K / BK;
  unsigned voffA[2], voffB[2];
#pragma unroll
  for (int i = 0; i < 2; ++i) { int R, C; stage_rc(tid * 16 + i * 8192, R, C); const int Rb = Epi::PERM ? ((R & ~31) + perm32(R & 31)) : R;
    voffA[i] = (unsigned)(R * g.lda + C) * 2u; voffB[i] = (unsigned)(Rb * g.ldb + C) * 2u; }
  const size_t kstep = (size_t)(BK * 2);
  const size_t hstepA = (size_t)HALF * g.lda * 2, hstepB = (size_t)HALF * g.ldb * 2;
  const size_t tstepA = 2 * hstepA, tstepB = 2 * hstepB;
  const unsigned ldsw = (unsigned)wid * 1024u;
#define PG8_SA(b, h) (((b) * 2 + (h)) * HTB)
#define PG8_SB(b, h) ((4 + (b) * 2 + (h)) * HTB)
#define PG8_STAGE(bufoff, gbase, voff) do { _Pragma("unroll") for (int _i = 0; _i < 2; ++_i) \
    __builtin_amdgcn_global_load_lds((const unsigned*)((const char*)(gbase) + (voff)[_i]), (LAS unsigned*)(lds + (bufoff) + ldsw + _i * 8192), 16, 0, 0); } while (0)
#define PG8_LDA(dst, b, h) do { _Pragma("unroll") for (int m = 0; m < 4; ++m) _Pragma("unroll") for (int k = 0; k < 2; ++k) dst[m][k] = *(const LAS bf16x8*)(lds + PG8_SA(b, h) + aoff + m * 2048 + k * 1024); } while (0)
#define PG8_LDB(dst, b, h) do { _Pragma("unroll") for (int n = 0; n < 2; ++n) _Pragma("unroll") for (int k = 0; k < 2; ++k) dst[n][k] = *(const LAS bf16x8*)(lds + PG8_SB(b, h) + boff + n * 2048 + k * 1024); } while (0)
#define PG8_MMA(ai, bj, At, Bt) do { __builtin_amdgcn_s_setprio(1); _Pragma("unroll") for (int m = 0; m < 4; ++m) _Pragma("unroll") for (int n = 0; n < 2; ++n) _Pragma("unroll") for (int k = 0; k < 2; ++k) \
    acc[ai][bj][m][n] = __builtin_amdgcn_mfma_f32_16x16x32_bf16(Bt[n][k], At[m][k], acc[ai][bj][m][n], 0, 0, 0); __builtin_amdgcn_s_setprio(0); } while (0)
#define PG8_WAIT_V(n) asm volatile("s_waitcnt vmcnt(" #n ")" ::: "memory")
#define PG8_WAIT_L(n) asm volatile("s_waitcnt lgkmcnt(" #n ")" ::: "memory")
#define PG8_BAR __builtin_amdgcn_s_barrier()
#define PG8_SCHED __builtin_amdgcn_sched_barrier(0)
  Unit cur, nxt; int ui = 0;
  if (!S.next(0, cur)) return;
  f32x4 acc[2][2][4][2];
#pragma unroll
  for (int a = 0; a < 2; ++a)
#pragma unroll
    for (int b = 0; b < 2; ++b)
#pragma unroll
      for (int m = 0; m < 4; ++m)
#pragma unroll
        for (int n = 0; n < 2; ++n) acc[a][b][m][n] = (f32x4){0.f, 0.f, 0.f, 0.f};
  bf16x8 At[4][2], B0[2][2], B1[2][2];
  const char* cA = (const char*)g.A + (size_t)cur.pm * tstepA; const char* cB = (const char*)g.Bt + (size_t)cur.pn * tstepB;
  PG8_STAGE(PG8_SB(0, 0), cB, voffB); PG8_STAGE(PG8_SA(0, 0), cA, voffA); PG8_STAGE(PG8_SB(0, 1), cB + hstepB, voffB); PG8_STAGE(PG8_SA(0, 1), cA + hstepA, voffA);
  if (wr == 1) PG8_BAR;
  PG8_WAIT_V(4); PG8_BAR;
  PG8_STAGE(PG8_SB(1, 0), cB + kstep, voffB); PG8_STAGE(PG8_SA(1, 0), cA + kstep, voffA); PG8_STAGE(PG8_SB(1, 1), cB + hstepB + kstep, voffB);
  PG8_WAIT_V(6); PG8_BAR;
  for (;;) {
    int t3 = threadIdx.x; asm volatile("" : "+v"(t3));
    const int aoff = lds_byte(wr * 64 + (t3 & 15), ((t3 & 63) >> 4) * 8), boff = lds_byte(wc * 32 + (t3 & 15), ((t3 & 63) >> 4) * 8);
    const bool has_next = S.next(ui + 1, nxt);
    const char* nA = has_next ? (const char*)g.A + (size_t)nxt.pm * tstepA : cA; const char* nB = has_next ? (const char*)g.Bt + (size_t)nxt.pn * tstepB : cB;
    for (int t = 0; t < nt; t += 2) {
      const bool last = (t == nt - 2);
      const char* a1 = cA + (size_t)(t + 1) * kstep;
      const char* a2 = last ? nA : cA + (size_t)(t + 2) * kstep; const char* b2 = last ? nB : cB + (size_t)(t + 2) * kstep;
      const char* a3 = a2 + kstep; const char* b3 = b2 + kstep;
      PG8_LDB(B0, 0, 0); PG8_SCHED; PG8_LDA(At, 0, 0); PG8_STAGE(PG8_SA(1, 1), a1 + hstepA, voffA);
      PG8_WAIT_L(8); PG8_BAR; PG8_WAIT_L(0); PG8_MMA(0, 0, At, B0); PG8_BAR; PG8_SCHED;
      PG8_LDB(B1, 0, 1); PG8_STAGE(PG8_SB(0, 0), b2, voffB);
      PG8_BAR; PG8_WAIT_L(0); PG8_MMA(0, 1, At, B1); PG8_BAR;
      PG8_LDA(At, 0, 1); PG8_STAGE(PG8_SA(0, 0), a2, voffA);
      PG8_BAR; PG8_WAIT_L(0); PG8_MMA(1, 0, At, B0); PG8_BAR; PG8_SCHED;
      PG8_STAGE(PG8_SB(0, 1), b2 + hstepB, voffB);
      PG8_WAIT_V(6); PG8_BAR; PG8_MMA(1, 1, At, B1); PG8_BAR;
      PG8_LDB(B0, 1, 0); PG8_SCHED; PG8_LDA(At, 1, 0); PG8_STAGE(PG8_SA(0, 1), a2 + hstepA, voffA);
      PG8_WAIT_L(8); PG8_BAR; PG8_WAIT_L(0); PG8_MMA(0, 0, At, B0); PG8_BAR; PG8_SCHED;
      PG8_LDB(B1, 1, 1); PG8_STAGE(PG8_SB(1, 0), b3, voffB);
      PG8_BAR; PG8_WAIT_L(0); PG8_MMA(0, 1, At, B1); PG8_BAR;
      PG8_LDA(At, 1, 1); PG8_STAGE(PG8_SA(1, 0), a3, voffA);
      PG8_BAR; PG8_WAIT_L(0); PG8_MMA(1, 0, At, B0); PG8_BAR; PG8_SCHED;
      PG8_STAGE(PG8_SB(1, 1), b3 + hstepB, voffB);
      PG8_WAIT_V(6); PG8_BAR; PG8_MMA(1, 1, At, B1); PG8_BAR;
    }
    { int t2 = threadIdx.x; asm volatile("" : "+v"(t2)); const int w2 = __builtin_amdgcn_readfirstlane(t2 >> 6), l2 = t2 & 63; E(acc, cur, w2 >> 2, w2 & 3, l2 & 15, l2 >> 4); }
    if (!has_next) break;
#pragma unroll
    for (int a = 0; a < 2; ++a)
#pragma unroll
      for (int b = 0; b < 2; ++b)
#pragma unroll
        for (int m = 0; m < 4; ++m)
#pragma unroll
          for (int n = 0; n < 2; ++n) acc[a][b][m][n] = (f32x4){0.f, 0.f, 0.f, 0.f};
    cur = nxt; cA = nA; cB = nB; ++ui;
  }
  PG8_WAIT_V(0);
  if (wr == 0) PG8_BAR;
  PG8_BAR;
#undef PG8_SA
#undef PG8_SB
#undef PG8_STAGE
#undef PG8_LDA
#undef PG8_LDB
#undef PG8_MMA
#undef PG8_WAIT_V
#undef PG8_WAIT_L
#undef PG8_BAR
#undef PG8_SCHED
}
typedef f32x4 Acc[2][2][4][2];

template <class F>
DI void store_perm(const f32x4 (&acc)[2][2][4][2], bf16_t* O, int ldc, int rowt, int colt, int wr, int wc, int fr, int fq, const F& f, bool skip_bj1) {
  const int row0 = rowt + wr * 64 + fr, col0 = colt + wc * 32 + 8 * fq;
#pragma unroll
  for (int ai = 0; ai < 2; ++ai)
#pragma unroll
    for (int m = 0; m < 4; ++m) { bf16_t* rowp = O + (size_t)(row0 + ai * HALF + m * 16) * ldc + col0;
#pragma unroll
      for (int bj = 0; bj < 2; ++bj) { if (bj == 1 && skip_bj1) continue;
        const f32x4 v0 = acc[ai][bj][m][0], v1 = acc[ai][bj][m][1];
        u32x4 w; w.x = pk2(f(v0[0], bj, 0), f(v0[1], bj, 1)); w.y = pk2(f(v0[2], bj, 2), f(v0[3], bj, 3)); w.z = pk2(f(v1[0], bj, 4), f(v1[1], bj, 5)); w.w = pk2(f(v1[2], bj, 6), f(v1[3], bj, 7));
        *(u32x4*)(rowp + bj * HALF) = w; }
      asm volatile("" ::: "memory"); }
}

struct EpiPlain {
  static constexpr bool PERM = true;
  bf16_t* O; int ldc;
  DI void operator()(const f32x4 (&acc)[2][2][4][2], const Unit& u, int wr, int wc, int fr, int fq) const {
    store_perm(acc, O, ldc, u.pm * BM, u.pn * BM, wr, wc, fr, fq, [](float v, int, int) { return v; }, false);
  }
};
struct EpiIn {
  static constexpr bool PERM = true;
  unsigned char* ws;
  DI void operator()(const f32x4 (&acc)[2][2][4][2], const Unit& u, int wr, int wc, int fr, int fq) const {
    const int pn = u.pn, rowt = u.pm * BM;
    size_t off; int ld, colt, act = 0;
    if (pn < 12) { off = pn < 4 ? WS_AB : pn < 8 ? WS_AC : WS_AX; ld = 1024; colt = (pn & 3) * 256; }
    else if (pn < 24) { off = WS_RKV; ld = 3072; colt = (pn - 12) * 256; }
    else if (pn == 24) { off = WS_LACT; ld = 512; colt = 0; act = 1; }
    else if (pn == 25) { off = WS_LACT; ld = 512; colt = 256; act = 2; }
    else if (pn < 30) { off = WS_Q; ld = 1024; colt = (pn - 26) * 256; }
    else if (pn == 30) { off = WS_K; ld = 256; colt = 0; }
    else { off = WS_GATES; ld = 3072; colt = (pn - 31) * 256; act = 3; }
    if (act == 0) store_perm(acc, (bf16_t*)(ws + off), ld, rowt, colt, wr, wc, fr, fq, [](float v, int, int) { return v; }, false);
    else store_perm(acc, (bf16_t*)(ws + off), ld, rowt, colt, wr, wc, fr, fq, [act](float v, int bj, int) { const bool th = act == 1 && bj == 0; const float sg = sigmoidf_(th ? 2.0f * v : v); return (act == 1 && bj == 1) ? v : (th ? 2.0f * sg - 1.0f : sg); }, act == 2);
  }
};
struct EpiLora {
  static constexpr bool PERM = true;
  unsigned char* ws; const float* w0; const float* a0;
  DI void operator()(const f32x4 (&acc)[2][2][4][2], const Unit& u, int wr, int wc, int fr, int fq) const {
    const int grp = u.pn >> 2, colt = (u.pn & 3) * 256, rowt = u.pm * BM;
    bf16_t* O = (bf16_t*)(ws + WS_LOUT + (size_t)grp * SZ16);
    const int cbase = colt + wc * 32 + 8 * fq;
    if (grp < 2) { const float* bp = w0 + grp * 1024 + cbase;
      store_perm(acc, O, 1024, rowt, colt, wr, wc, fr, fq, [bp](float v, int bj, int j) { return 0.60653066f * sigmoidf_(v + bp[bj * HALF + j]); }, false); }
    else if (grp < 4) { const float* bp = a0 + (grp - 2) * 1024 + cbase;
      store_perm(acc, O, 1024, rowt, colt, wr, wc, fr, fq, [bp](float v, int bj, int j) { return sigmoidf_(v + bp[bj * HALF + j]); }, false); }
    else store_perm(acc, O, 1024, rowt, colt, wr, wc, fr, fq, [](float v, int, int) { return v; }, false);
  }
};
template <int BR>
struct EpiMerge {
  static constexpr bool PERM = false;
  unsigned char* ws;
  DI void operator()(const f32x4 (&acc)[2][2][4][2], const Unit& u, int wr, int wc, int fr, int fq) const {
    const int row0 = u.pm * BM + wr * 64 + fr, col0 = u.pn * BM + wc * 32 + 4 * fq;
    const bf16_t* G = (const bf16_t*)(ws + WS_GATES); float* M32 = (float*)(ws + WS_RKV); bf16_t* M16 = (bf16_t*)(ws + WS_YB2);
#pragma unroll
    for (int ai = 0; ai < 2; ++ai)
#pragma unroll
      for (int m = 0; m < 4; ++m) { const size_t row = (size_t)(row0 + ai * HALF + m * 16);
#pragma unroll
        for (int bj = 0; bj < 2; ++bj)
#pragma unroll
          for (int n = 0; n < 2; ++n) { const int c = col0 + bj * HALF + n * 16;
            const u32x2 gw = *(const u32x2*)(G + row * 3072 + BR * 1024 + c);
            f32x4 gv = {bflo(gw.x), bfhi(gw.x), bflo(gw.y), bfhi(gw.y)};
            f32x4 v = gv * acc[ai][bj][m][n];
            float* mp = M32 + row * 1024 + c;
            if (BR > 0) v += *(const f32x4*)mp;
            if (BR < 2) *(f32x4*)mp = v;
            else { u32x2 w; w.x = pk2(v[0], v[1]); w.y = pk2(v[2], v[3]); *(u32x2*)(M16 + row * 1024 + c) = w; } }
        asm volatile("" ::: "memory"); }
  }
};
struct EpiRes {
  static constexpr bool PERM = false;
  const float* baseL; const float* baseC; float* outL; float* outC; const float* mod;
  DI void operator()(const f32x4 (&acc)[2][2][4][2], const Unit& u, int wr, int wc, int fr, int fq) const {
    const bool isc = u.pm >= 64; const int r3 = u.pm < 32 ? 0 : (u.pm < 64 ? 1 : 2);
    const float* base = isc ? baseC - (size_t)NTL * 1024 : baseL; float* out = isc ? outC - (size_t)NTL * 1024 : outL;
    const int row0 = u.pm * BM + wr * 64 + fr, col0 = u.pn * BM + wc * 32 + 4 * fq;
    const float* mv = mod + r3 * 6144;
#pragma unroll
    for (int ai = 0; ai < 2; ++ai)
#pragma unroll
      for (int m = 0; m < 4; ++m) { const size_t off = (size_t)(row0 + ai * HALF + m * 16) * 1024;
#pragma unroll
        for (int bj = 0; bj < 2; ++bj)
#pragma unroll
          for (int n = 0; n < 2; ++n) { const int c = col0 + bj * HALF + n * 16;
            const f32x4 g = *(const f32x4*)(mv + c); const f32x4 b = *(const f32x4*)(base + off + c);
            *(f32x4*)(out + off + c) = b + g * acc[ai][bj][m][n]; }
        asm volatile("" ::: "memory"); }
  }
};
}
struct Ctx { int tid, lane, wave, bid, nb; unsigned char* lds; };

DI void conv_tile(const Ctx& c, bf16_t* dst, int ldd, const float* src, int ldsrc) {
  float* t = (float*)c.lds;
  if (src) {
#pragma unroll
    for (int i = 0; i < 8; ++i) { const int e = c.tid + i * NTHR, kk = e >> 6, nn = e & 63; t[kk * 65 + nn] = src[(size_t)kk * ldsrc + nn]; }
  }
  __syncthreads();
#pragma unroll
  for (int i = 0; i < 4; ++i) { const int e = c.tid + i * NTHR, nn = e >> 5, kp = e & 31;
    unsigned w = 0u; if (src) w = pk2(t[(2 * kp) * 65 + nn], t[(2 * kp + 1) * 65 + nn]);
    *(unsigned*)(dst + (size_t)nn * ldd + 2 * kp) = w; }
  __syncthreads();
}
DI void phase_convert(const Ctx& c, PP p, int l) {
  unsigned char* ws = p->ws;
  for (int t = c.bid; t < 6432; t += c.nb) {
    if (t < 2816) { const int nt = t >> 4, kt = t & 15; const int n0 = nt * 64, k0 = kt * 64;
      const float* W = p->in[7] + (size_t)l * 1024 * NIN;
      bf16_t* dst; int srccol;
      if (n0 < 6528) { dst = (bf16_t*)(ws + WS_WIN) + (size_t)n0 * 1024; srccol = n0; }
      else if (n0 < 6656) { dst = (bf16_t*)(ws + WS_WIN) + (size_t)n0 * 1024; srccol = -1; }
      else if (n0 < 7936) { dst = (bf16_t*)(ws + WS_WIN) + (size_t)n0 * 1024; srccol = n0 - 128; }
      else if (n0 < 11008) { dst = (bf16_t*)(ws + WS_WIN) + (size_t)n0 * 1024; srccol = n0 - 7936 + 8064; }
      else { dst = (bf16_t*)(ws + WS_WV) + (size_t)(n0 - 11008) * 1024; srccol = n0 - 11008 + 7808; }
      conv_tile(c, dst + k0, 1024, srccol < 0 ? nullptr : W + (size_t)k0 * NIN + srccol, NIN);
    } else if (t < 3296) { const int u = t - 2816, nt = u / 6, kt = u % 6; const int n0 = nt * 64, k0 = kt * 64, grp = n0 >> 10, nc = n0 & 1023;
      const float* src = nullptr;
      if (grp < 2) { if (kt == grp) src = p->in[12] + ((size_t)(l * 2 + grp) * 64) * 1024 + nc; }
      else if (grp < 4) { if (kt == grp) src = p->in[14] + ((size_t)(l * 2 + grp - 2) * 64) * 1024 + nc; }
      else { if (kt >= 4) src = p->in[15] + ((size_t)l * 128 + (kt - 4) * 64) * 1024 + nc; }
      conv_tile(c, (bf16_t*)(ws + WS_WLORA) + (size_t)n0 * 384 + k0, 384, src, 1024);
    } else if (t < 4320) { const int u = t - 3296, which = u >> 8, v = u & 255, nt = v >> 4, kt = v & 15;
      const int idx = which == 0 ? 9 : which == 1 ? 21 : which == 2 ? 23 : 24;
      const float* W = p->in[idx] + (size_t)l * 1024 * 1024;
      conv_tile(c, (bf16_t*)(ws + WS_WA + (size_t)which * AL((size_t)1024 * 1024 * 2)) + (size_t)(nt * 64) * 1024 + kt * 64, 1024, W + (size_t)(kt * 64) * 1024 + nt * 64, 1024);
    } else if (t < 5728) { const int u = t - 4320, nt = u >> 4, kt = u & 15;
      const float* W = p->in[26] + (size_t)l * 1024 * 5632;
      conv_tile(c, (bf16_t*)(ws + WS_WUP) + (size_t)(nt * 64) * 1024 + kt * 64, 1024, W + (size_t)(kt * 64) * 5632 + nt * 64, 5632);
    } else { const int u = t - 5728, nt = u / 44, kt = u % 44;
      const float* W = p->in[28] + (size_t)l * 2816 * 1024;
      conv_tile(c, (bf16_t*)(ws + WS_WDN) + (size_t)(nt * 64) * 2816 + kt * 64, 2816, W + (size_t)(kt * 64) * 1024 + nt * 64, 1024);
    }
  }
}

DI void phase_mods(const Ctx& c, PP p) {
  float* s = (float*)c.lds;
  float* red = s + 3 * 1024;
  for (int i = c.tid; i < 3072; i += NTHR) { const float v = i < 2048 ? p->in[1][i] : p->in[3][i - 2048]; s[i] = v * sigmoidf_(v); }
  __syncthreads();
  float* mod = (float*)(p->ws + WS_MOD);
  const int col = c.tid & 63, kg = c.tid >> 6;
  for (int it = c.bid; it < DEPTH * 96; it += c.nb) {
    const int l = it / 96, j0 = (it % 96) * 64;
    const float* W = p->in[4] + (size_t)l * 1024 * 6144 + j0 + col;
    float a0 = 0.f, a1 = 0.f, a2 = 0.f;
#pragma unroll 8
    for (int k = kg * 128; k < kg * 128 + 128; ++k) { const float w = W[(size_t)k * 6144]; a0 += s[k] * w; a1 += s[1024 + k] * w; a2 += s[2048 + k] * w; }
    red[(kg * 3 + 0) * 64 + col] = a0; red[(kg * 3 + 1) * 64 + col] = a1; red[(kg * 3 + 2) * 64 + col] = a2;
    __syncthreads();
    if (c.tid < 192) { const int r = c.tid >> 6; float v = p->in[5][(size_t)l * 6144 + j0 + col];
#pragma unroll
      for (int g = 0; g < 8; ++g) v += red[(g * 3 + r) * 64 + col];
      mod[((size_t)l * 3 + r) * 6144 + j0 + col] = v; }
    __syncthreads();
  }
  const int gt = c.bid * NTHR + c.tid;
  if (gt < 2048) { const int pos = gt >> 4, f = gt & 15; const float inv = powf(10000.0f, -(float)f / 16.0f); const float ang = (float)pos * inv;
    float* rope = (float*)(p->ws + WS_ROPE); rope[gt] = cosf(ang); rope[2048 + gt] = sinf(ang); }
}

DI void phase_norm(const Ctx& c, PP p, const float* xL, const float* xC, const float* g, const float* mod  , int shift_idx) {
  bf16_t* H = (bf16_t*)(p->ws + WS_H);
  for (int row = c.bid * 8 + c.wave; row < NTOK; row += c.nb * 8) {
    const float* xr = row < NTL ? xL + (size_t)row * 1024 : xC + (size_t)(row - NTL) * 1024;
    const int r3 = row < SEQ ? 0 : (row < NTL ? 1 : 2);
    const float* sh = mod + r3 * 6144 + shift_idx * 1024; const float* sc = sh + 1024;
    f32x4 v[4]; float ss = 0.f;
#pragma unroll
    for (int i = 0; i < 4; ++i) { v[i] = *(const f32x4*)(xr + i * 256 + c.lane * 4); ss += v[i][0] * v[i][0] + v[i][1] * v[i][1] + v[i][2] * v[i][2] + v[i][3] * v[i][3]; }
    ss = wave_sum(ss);
    const float rs = rsqrtf(ss * (1.0f / 1024.0f) + 1e-6f);
#pragma unroll
    for (int i = 0; i < 4; ++i) { const int col = i * 256 + c.lane * 4;
      const f32x4 gg = *(const f32x4*)(g + col), s1 = *(const f32x4*)(sc + col), s0 = *(const f32x4*)(sh + col);
      const f32x4 h = v[i] * rs * gg * (1.0f + s1) + s0;
      u32x2 w; w.x = pk2(h[0], h[1]); w.y = pk2(h[2], h[3]); *(u32x2*)(H + (size_t)row * 1024 + col) = w; }
  }
}

DI void phase_final(const Ctx& c, PP p) {
  const float* g = p->in[29];
  for (int row = c.bid * 8 + c.wave; row < NTL; row += c.nb * 8) {
    float* xr = p->out + (size_t)row * 1024;
    f32x4 v[4]; float ss = 0.f;
#pragma unroll
    for (int i = 0; i < 4; ++i) { v[i] = *(const f32x4*)(xr + i * 256 + c.lane * 4); ss += v[i][0] * v[i][0] + v[i][1] * v[i][1] + v[i][2] * v[i][2] + v[i][3] * v[i][3]; }
    ss = wave_sum(ss);
    const float rs = rsqrtf(ss * (1.0f / 1024.0f) + 1e-6f);
#pragma unroll
    for (int i = 0; i < 4; ++i) { const int col = i * 256 + c.lane * 4; *(f32x4*)(xr + col) = v[i] * rs * *(const f32x4*)(g + col); }
  }
}

DI void unpack8(const u32x4 w, float (&f)[8]) { f[0] = bflo(w.x); f[1] = bfhi(w.x); f[2] = bflo(w.y); f[3] = bfhi(w.y); f[4] = bflo(w.z); f[5] = bfhi(w.z); f[6] = bflo(w.w); f[7] = bfhi(w.w); }
DI void seq_of_row(int row0, int& pos0, int& seqlen) { if (row0 < NTL) { pos0 = row0 & (SEQ - 1); seqlen = SEQ; } else { pos0 = (row0 - NTL) & (CTXL - 1); seqlen = CTXL; } }

DI void phase_conv_a(const Ctx& c, PP p, int l) {
  bf16_t* AB = (bf16_t*)(p->ws + WS_AB); const bf16_t* AC = (const bf16_t*)(p->ws + WS_AC); const bf16_t* AX = (const bf16_t*)(p->ws + WS_AX);
  const float* cw = p->in[8] + (size_t)l * 3 * 1024;
  const int nitems = (NTOK / 8) * 128;
  for (int it = c.bid * NTHR + c.tid; it < nitems; it += c.nb * NTHR) {
    const int rb = it >> 7, ch = it & 127, row0 = rb * 8, col = ch * 8; int pos0, seqlen; seq_of_row(row0, pos0, seqlen);
    float w0[8], w1[8], w2[8];
#pragma unroll
    for (int j = 0; j < 8; ++j) { w0[j] = cw[col + j]; w1[j] = cw[1024 + col + j]; w2[j] = cw[2048 + col + j]; }
    float zp[8], zc[8], zn[8];
    auto loadz = [&](int row, float (&z)[8]) { float a[8], b[8]; unpack8(*(const u32x4*)(AC + (size_t)row * 1024 + col), a); unpack8(*(const u32x4*)(AX + (size_t)row * 1024 + col), b);
#pragma unroll
      for (int j = 0; j < 8; ++j) z[j] = a[j] * b[j]; };
    if (pos0 > 0) loadz(row0 - 1, zp); else {
#pragma unroll
      for (int j = 0; j < 8; ++j) zp[j] = 0.f; }
    loadz(row0, zc);
#pragma unroll
    for (int r = 0; r < 8; ++r) {
      if (pos0 + r + 1 < seqlen) loadz(row0 + r + 1, zn); else {
#pragma unroll
        for (int j = 0; j < 8; ++j) zn[j] = 0.f; }
      float b[8]; unpack8(*(const u32x4*)(AB + (size_t)(row0 + r) * 1024 + col), b);
      float o[8];
#pragma unroll
      for (int j = 0; j < 8; ++j) { o[j] = b[j] * (zp[j] * w0[j] + zc[j] * w1[j] + zn[j] * w2[j]); zp[j] = zc[j]; zc[j] = zn[j]; }
      u32x4 w; w.x = pk2(o[0], o[1]); w.y = pk2(o[2], o[3]); w.z = pk2(o[4], o[5]); w.w = pk2(o[6], o[7]);
      *(u32x4*)(AB + (size_t)(row0 + r) * 1024 + col) = w;
    }
  }
}

DI void phase_ffn_act(const Ctx& c, PP p, int l) {
  const bf16_t* U = (const bf16_t*)(p->ws + WS_U); bf16_t* ACT = (bf16_t*)(p->ws + WS_GATES);
  const float* cw = p->in[27] + (size_t)l * 3 * 5632;
  const int nitems = (NTOK / 8) * 352;
  for (int it = c.bid * NTHR + c.tid; it < nitems; it += c.nb * NTHR) {
    const int rb = it / 352, ch = it % 352, row0 = rb * 8, col = ch * 8; int pos0, seqlen; seq_of_row(row0, pos0, seqlen);
    float gp[8], gc[8], gn[8], vp[8], vc[8], vn[8];
    auto ld = [&](int row, float (&a)[8], float (&b)[8]) { unpack8(*(const u32x4*)(U + (size_t)row * 5632 + col), a); unpack8(*(const u32x4*)(U + (size_t)row * 5632 + 2816 + col), b); };
    if (pos0 > 0) ld(row0 - 1, gp, vp); else {
#pragma unroll
      for (int j = 0; j < 8; ++j) { gp[j] = 0.f; vp[j] = 0.f; } }
    ld(row0, gc, vc);
#pragma unroll
    for (int r = 0; r < 8; ++r) {
      if (pos0 + r + 1 < seqlen) ld(row0 + r + 1, gn, vn); else {
#pragma unroll
        for (int j = 0; j < 8; ++j) { gn[j] = 0.f; vn[j] = 0.f; } }
      float o[8];
#pragma unroll
      for (int j = 0; j < 8; ++j) {
        const float ug = gp[j] * cw[col + j] + gc[j] * cw[5632 + col + j] + gn[j] * cw[2 * 5632 + col + j];
        const float uv = vp[j] * cw[2816 + col + j] + vc[j] * cw[5632 + 2816 + col + j] + vn[j] * cw[2 * 5632 + 2816 + col + j];
        o[j] = ug * sigmoidf_(ug) * uv; gp[j] = gc[j]; gc[j] = gn[j]; vp[j] = vc[j]; vc[j] = vn[j]; }
      u32x4 w; w.x = pk2(o[0], o[1]); w.y = pk2(o[2], o[3]); w.z = pk2(o[4], o[5]); w.w = pk2(o[6], o[7]);
      *(u32x4*)(ACT + (size_t)(row0 + r) * 2816 + col) = w;
    }
  }
}

DI void phase_rwkv_fin(const Ctx& c, PP p, int l) {
  bf16_t* YF = (bf16_t*)(p->ws + WS_H); const bf16_t* YB = (const bf16_t*)(p->ws + WS_YB2); const bf16_t* RKV = (const bf16_t*)(p->ws + WS_RKV);
  const bf16_t* AS0 = (const bf16_t*)(p->ws + WS_LOUT + 2 * SZ16); const bf16_t* AS1 = (const bf16_t*)(p->ws + WS_LOUT + 3 * SZ16); const bf16_t* GG = (const bf16_t*)(p->ws + WS_LOUT + 4 * SZ16);
  const float* mu = p->in[10] + (size_t)l * 2 * 3072; const float* ka = p->in[17] + (size_t)l * 1024; const float* rk = p->in[18] + (size_t)l * 1024;
  const float* lg = p->in[19] + (size_t)l * 1024; const float* lb = p->in[20] + (size_t)l * 1024;
  const int ntok = (l == DEPTH - 1) ? NTL : NTOK;
  for (int row = c.bid * 8 + c.wave; row < ntok; row += c.nb * 8) {
    int pos, seqlen; seq_of_row(row, pos, seqlen);
    const float mp = pos > 0 ? 1.f : 0.f, mn = pos + 1 < seqlen ? 1.f : 0.f;
    const bf16_t* r0 = RKV + (size_t)(pos > 0 ? row - 1 : row) * 3072; const bf16_t* r1 = RKV + (size_t)row * 3072; const bf16_t* r2 = RKV + (size_t)(pos + 1 < seqlen ? row + 1 : row) * 3072;
    for (int h = 0; h < 16; ++h) {
      const int ch = h * 64 + c.lane;
      float x[3];
#pragma unroll
      for (int q = 0; q < 3; ++q) { const int cc = q * 1024 + ch; const float m0 = mu[cc], m1 = mu[3072 + cc];
        x[q] = mp * m0 * bf2f(r0[cc]) + (1.0f - m0 - m1) * bf2f(r1[cc]) + mn * m1 * bf2f(r2[cc]); }
      const size_t o = (size_t)row * 1024 + ch;
      const float a0 = bf2f(AS0[o]), a1 = bf2f(AS1[o]), kav = ka[ch];
      const float kd0 = x[1] * (1.0f + (a0 - 1.0f) * kav), kd1 = x[1] * (1.0f + (a1 - 1.0f) * kav);
      const float rr = x[0] * rk[ch];
      float s01 = rr * (kd0 + kd1);
      const float y = bf2f(YF[o]) + bf2f(YB[o]);
      float sy = y;
#pragma unroll
      for (int of = 32; of >= 1; of >>= 1) { s01 += __shfl_xor(s01, of); sy += __shfl_xor(sy, of); }
      const float mean = sy * (1.0f / 64.0f), d = y - mean;
      const float var = wave_sum(d * d) * (1.0f / 64.0f);
      const float gn = d * rsqrtf(var + 64e-5f) * lg[ch] + lb[ch];
      const float outv = (gn + s01 * x[2]) * bf2f(GG[o]);
      YF[o] = (bf16_t)(pk2(outv, 0.f) & 0xffffu);
    }
  }
}
#define MFMA32(a, b, c) __builtin_amdgcn_mfma_f32_32x32x16_bf16((a), (b), (c), 0, 0, 0)
constexpr int KS_LD = 72, VS_LD = 136;
constexpr float QSCALE = 0.125f * 1.4426950408889634f;

DI void attn_unit(const Ctx& c, PP p, int l, int unit) {
  bf16_t* Ks = (bf16_t*)c.lds; bf16_t* Vs = Ks + 128 * KS_LD;
  const bf16_t* Q = (const bf16_t*)(p->ws + WS_Q); const bf16_t* Kg = (const bf16_t*)(p->ws + WS_K); const bf16_t* Vt = (const bf16_t*)(p->ws + WS_VT);
  bf16_t* O = (bf16_t*)(p->ws + WS_Q);
  const float* ropec = (const float*)(p->ws + WS_ROPE); const float* ropes = ropec + 2048;
  const bool isctx = unit >= 512;
  int b, n, g, qrow0;
  if (!isctx) { b = unit >> 8; n = (unit >> 2) & 63; g = unit & 3; qrow0 = b * SEQ + n * 128; }
  else { const int uu = unit - 512; b = uu >> 3; n = (uu >> 2) & 1; g = uu & 3; qrow0 = NTL + b * CTXL + n * 128; }
  const int lane = c.lane, w = c.wave, r = lane & 31, h = lane >> 5;
  const int head = 4 * g + (w >> 1), qoff = 64 * (w & 1);
  bf16x8 qf[2][4];
#pragma unroll
  for (int tl = 0; tl < 2; ++tl) {
    const int qi = qoff + 32 * tl + r, tr = qrow0 + qi;
    const bf16_t* qp = Q + (size_t)tr * 1024 + head * 64 + 8 * h;
    float x[4][8];
#pragma unroll
    for (int s = 0; s < 4; ++s) unpack8(*(const u32x4*)(qp + 16 * s), x[s]);
    if (!isctx) {
      const int t = n * 128 + qi; const int pr = t >> 6, pc = t & 63;
#pragma unroll
      for (int ax = 0; ax < 2; ++ax) { const int pos = ax ? pc : pr;
#pragma unroll
        for (int j = 0; j < 8; ++j) { const float cs = ropec[pos * 16 + 8 * h + j], sn = ropes[pos * 16 + 8 * h + j];
          const float x1 = x[2 * ax][j], x2 = x[2 * ax + 1][j]; x[2 * ax][j] = x1 * cs - x2 * sn; x[2 * ax + 1][j] = x1 * sn + x2 * cs; } }
    }
#pragma unroll
    for (int s = 0; s < 4; ++s) { u32x4 wv; wv.x = pk2(x[s][0] * QSCALE, x[s][1] * QSCALE); wv.y = pk2(x[s][2] * QSCALE, x[s][3] * QSCALE); wv.z = pk2(x[s][4] * QSCALE, x[s][5] * QSCALE); wv.w = pk2(x[s][6] * QSCALE, x[s][7] * QSCALE);
      qf[tl][s] = __builtin_bit_cast(bf16x8, wv); }
  }
  f32x16 oacc[2][2];
  float mrun[2], lrun[2];
#pragma unroll
  for (int tl = 0; tl < 2; ++tl) { mrun[tl] = -1e30f; lrun[tl] = 0.f;
#pragma unroll
    for (int dh = 0; dh < 2; ++dh)
#pragma unroll
      for (int i = 0; i < 16; ++i) oacc[tl][dh][i] = 0.f; }
  const int ntile = isctx ? 2 : 5;
  for (int ti = 0; ti < ntile; ++ti) {
    int krow0, mode = 0; bool rope = false;
    if (isctx) krow0 = NTL + b * CTXL + ti * 128;
    else if (ti == 0) { krow0 = b * SEQ + n * 128; rope = true; }
    else if (ti == 1) { if (n == 0) continue; krow0 = b * SEQ + (n - 1) * 128; mode = 1; rope = true; }
    else if (ti == 2) { if (n == 63) continue; krow0 = b * SEQ + (n + 1) * 128; mode = 2; rope = true; }
    else krow0 = NTL + b * CTXL + (ti - 3) * 128;
    __syncthreads();
    {
      const int kr = c.tid >> 2, pcx = c.tid & 3, c1 = (pcx & 1) + 4 * (pcx >> 1), ax = pcx >> 1;
      const bf16_t* kp = Kg + (size_t)(krow0 + kr) * 256 + g * 64;
      float x1[8], x2[8]; unpack8(*(const u32x4*)(kp + 8 * c1), x1); unpack8(*(const u32x4*)(kp + 8 * c1 + 16), x2);
      if (rope) { const int t = (krow0 + kr) & (SEQ - 1); const int pos = ax ? (t & 63) : (t >> 6); const int f0 = 8 * (pcx & 1);
#pragma unroll
        for (int j = 0; j < 8; ++j) { const float cs = ropec[pos * 16 + f0 + j], sn = ropes[pos * 16 + f0 + j]; const float a = x1[j], bb = x2[j]; x1[j] = a * cs - bb * sn; x2[j] = a * sn + bb * cs; } }
      u32x4 w1, w2; w1.x = pk2(x1[0], x1[1]); w1.y = pk2(x1[2], x1[3]); w1.z = pk2(x1[4], x1[5]); w1.w = pk2(x1[6], x1[7]);
      w2.x = pk2(x2[0], x2[1]); w2.y = pk2(x2[2], x2[3]); w2.z = pk2(x2[4], x2[5]); w2.w = pk2(x2[6], x2[7]);
      *(u32x4*)(Ks + kr * KS_LD + 8 * c1) = w1; *(u32x4*)(Ks + kr * KS_LD + 8 * c1 + 16) = w2;
#pragma unroll
      for (int rep = 0; rep < 2; ++rep) { const int i = c.tid + rep * NTHR, d = i >> 4, chn = i & 15;
        *(u32x4*)(Vs + d * VS_LD + 8 * chn) = *(const u32x4*)(Vt + (size_t)(g * 64 + d) * NTOK + krow0 + 8 * chn); }
    }
    __syncthreads();
#pragma unroll 1
    for (int ks = 0; ks < 4; ++ks) {
      bf16x8 kf[4];
#pragma unroll
      for (int s = 0; s < 4; ++s) kf[s] = *(const bf16x8*)(Ks + (32 * ks + r) * KS_LD + 16 * s + 8 * h);
      bf16x8 vf[2][2];
#pragma unroll
      for (int dh = 0; dh < 2; ++dh)
#pragma unroll
        for (int s = 0; s < 2; ++s) { const bf16_t* vp = Vs + (32 * dh + r) * VS_LD + 32 * ks + 16 * s + 4 * h;
          const s16x4 lo = *(const s16x4*)vp, hi = *(const s16x4*)(vp + 8); vf[dh][s] = __builtin_shufflevector(lo, hi, 0, 1, 2, 3, 4, 5, 6, 7); }
#pragma unroll
      for (int tl = 0; tl < 2; ++tl) {
        f32x16 x;
#pragma unroll
        for (int i = 0; i < 16; ++i) x[i] = 0.f;
#pragma unroll
        for (int s = 0; s < 4; ++s) x = MFMA32(kf[s], qf[tl][s], x);
        const int qi = qoff + 32 * tl + r;
        if (mode) {
#pragma unroll
          for (int i = 0; i < 16; ++i) { const int kj = 32 * ks + (i & 3) + 8 * (i >> 2) + 4 * h; const bool ok = mode == 1 ? (kj >= qi) : (kj <= qi); x[i] = ok ? x[i] : -1e30f; }
        }
        float mx = x[0];
#pragma unroll
        for (int i = 1; i < 16; ++i) mx = fmaxf(mx, x[i]);
        mx = fmaxf(mx, __shfl_xor(mx, 32));
        const float mnew = fmaxf(mrun[tl], mx), alpha = __builtin_amdgcn_exp2f(mrun[tl] - mnew);
        float ps = 0.f;
#pragma unroll
        for (int i = 0; i < 16; ++i) { x[i] = __builtin_amdgcn_exp2f(x[i] - mnew); ps += x[i]; }
        ps += __shfl_xor(ps, 32);
        lrun[tl] = lrun[tl] * alpha + ps; mrun[tl] = mnew;
#pragma unroll
        for (int dh = 0; dh < 2; ++dh)
#pragma unroll
          for (int i = 0; i < 16; ++i) oacc[tl][dh][i] *= alpha;
#pragma unroll
        for (int s = 0; s < 2; ++s) { u32x4 pw; pw.x = pk2(x[8 * s], x[8 * s + 1]); pw.y = pk2(x[8 * s + 2], x[8 * s + 3]); pw.z = pk2(x[8 * s + 4], x[8 * s + 5]); pw.w = pk2(x[8 * s + 6], x[8 * s + 7]);
          const bf16x8 pf = __builtin_bit_cast(bf16x8, pw);
          oacc[tl][0] = MFMA32(vf[0][s], pf, oacc[tl][0]); oacc[tl][1] = MFMA32(vf[1][s], pf, oacc[tl][1]); }
      }
    }
  }
  const float sink = p->in[22][l * 16 + head] * 1.4426950408889634f;
#pragma unroll
  for (int tl = 0; tl < 2; ++tl) {
    const float lt = lrun[tl] + __builtin_amdgcn_exp2f(sink - mrun[tl]); const float inv = 1.0f / lt;
    const int tr = qrow0 + qoff + 32 * tl + r;
    bf16_t* op = O + (size_t)tr * 1024 + head * 64;
#pragma unroll
    for (int dh = 0; dh < 2; ++dh)
#pragma unroll
      for (int gq = 0; gq < 4; ++gq) { u32x2 wv; wv.x = pk2(oacc[tl][dh][4 * gq] * inv, oacc[tl][dh][4 * gq + 1] * inv); wv.y = pk2(oacc[tl][dh][4 * gq + 2] * inv, oacc[tl][dh][4 * gq + 3] * inv);
        *(u32x2*)(op + 32 * dh + 8 * gq + 4 * h) = wv; }
  }
  __syncthreads();
}

constexpr int SC_CH = 32;
constexpr int SC_STEP_F = 5 * 64 + 16;
constexpr int SC_BUF_F = SC_CH * SC_STEP_F;
constexpr int SC_NCHUNK = (CTXL + SEQ) / SC_CH;

struct ScanRegs { unsigned rk[4][9]; unsigned ev[4], av[4]; };

DI int scan_row(int s, int dir, int b, int& pos, int& seqlen) {
  if (s < CTXL) { pos = dir ? CTXL - 1 - s : s; seqlen = CTXL; return NTL + b * CTXL + pos; }
  const int s2 = s - CTXL; pos = dir ? SEQ - 1 - s2 : s2; seqlen = SEQ; return b * SEQ + pos;
}

DI void phase_scan(const Ctx& c, PP p, int l) {
  float* bufs = (float*)c.lds;
  float* ybuf = bufs + 2 * SC_BUF_F;
  const int xcd = c.bid & 7, slot = c.bid >> 3;
  const int chain = xcd * 8 + (slot >> 2), part = slot & 3;
  const int dir = chain >> 5, b = (chain >> 4) & 1, hd = chain & 15;
  const bf16_t* RKV = (const bf16_t*)(p->ws + WS_RKV);
  const bf16_t* EE = (const bf16_t*)(p->ws + WS_LOUT + (size_t)dir * SZ16); const bf16_t* AS = (const bf16_t*)(p->ws + WS_LOUT + (size_t)(2 + dir) * SZ16);
  bf16_t* Y = (bf16_t*)(p->ws + (dir ? WS_YB2 : WS_H));
  const bool loader = c.wave >= 4;
  const int lt = c.tid - 256, lw = lt >> 6, half = (c.lane >> 5), cp = c.lane & 31;
  float mu0[3][2], mu1[3][2], kkw[2], kaw[2];
  if (loader) {
    const float* mu = p->in[10] + (size_t)l * 2 * 3072;
#pragma unroll
    for (int q = 0; q < 3; ++q)
#pragma unroll
      for (int e = 0; e < 2; ++e) { const int cc = q * 1024 + hd * 64 + 2 * cp + e; mu0[q][e] = mu[cc]; mu1[q][e] = mu[3072 + cc]; }
#pragma unroll
    for (int e = 0; e < 2; ++e) { kkw[e] = p->in[16][(size_t)l * 1024 + hd * 64 + 2 * cp + e]; kaw[e] = p->in[17][(size_t)l * 1024 + hd * 64 + 2 * cp + e]; }
  }
  ScanRegs R;
  auto issue = [&](int chunk) {
#pragma unroll
    for (int i = 0; i < 4; ++i) { const int s = chunk * SC_CH + 8 * i + 2 * lw + half; int pos, seqlen; const int row = scan_row(s, dir, b, pos, seqlen);
      const int rp = pos > 0 ? row - 1 : row, rn = pos + 1 < seqlen ? row + 1 : row;
#pragma unroll
      for (int q = 0; q < 3; ++q) { const int cc = q * 1024 + hd * 64 + 2 * cp;
        R.rk[i][q * 3 + 0] = *(const unsigned*)(RKV + (size_t)rp * 3072 + cc); R.rk[i][q * 3 + 1] = *(const unsigned*)(RKV + (size_t)row * 3072 + cc); R.rk[i][q * 3 + 2] = *(const unsigned*)(RKV + (size_t)rn * 3072 + cc); }
      R.ev[i] = *(const unsigned*)(EE + (size_t)row * 1024 + hd * 64 + 2 * cp); R.av[i] = *(const unsigned*)(AS + (size_t)row * 1024 + hd * 64 + 2 * cp); }
  };
  auto process = [&](int chunk, float* buf) {
#pragma unroll
    for (int i = 0; i < 4; ++i) { const int j = 8 * i + 2 * lw + half; const int s = chunk * SC_CH + j; int pos, seqlen; (void)scan_row(s, dir, b, pos, seqlen);
      const float mp = pos > 0 ? 1.f : 0.f, mn = pos + 1 < seqlen ? 1.f : 0.f;
      float x[3][2];
#pragma unroll
      for (int q = 0; q < 3; ++q) {
        x[q][0] = mp * mu0[q][0] * bflo(R.rk[i][q * 3]) + (1.0f - mu0[q][0] - mu1[q][0]) * bflo(R.rk[i][q * 3 + 1]) + mn * mu1[q][0] * bflo(R.rk[i][q * 3 + 2]);
        x[q][1] = mp * mu0[q][1] * bfhi(R.rk[i][q * 3]) + (1.0f - mu0[q][1] - mu1[q][1]) * bfhi(R.rk[i][q * 3 + 1]) + mn * mu1[q][1] * bfhi(R.rk[i][q * 3 + 2]); }
      const float k0 = x[1][0] * kkw[0], k1 = x[1][1] * kkw[1];
      float ss = k0 * k0 + k1 * k1;
#pragma unroll
      for (int of = 16; of >= 1; of >>= 1) ss += __shfl_xor(ss, of);
      const float nr = rsqrtf(ss + 1e-12f);
      const float kn0 = k0 * nr, kn1 = k1 * nr;
      const float e0 = bflo(R.ev[i]), e1 = bfhi(R.ev[i]), a0 = bflo(R.av[i]), a1 = bfhi(R.av[i]);
      float* st = buf + j * SC_STEP_F;
      *(f32x2*)(st + 0 * 64 + 2 * cp) = (f32x2){-kn0, -kn1};
      *(f32x2*)(st + 1 * 64 + 2 * cp) = (f32x2){__expf(-e0), __expf(-e1)};
      *(f32x2*)(st + 2 * 64 + 2 * cp) = (f32x2){kn0 * a0, kn1 * a1};
      *(f32x2*)(st + 3 * 64 + 2 * cp) = (f32x2){x[1][0] * (1.0f + (a0 - 1.0f) * kaw[0]), x[1][1] * (1.0f + (a1 - 1.0f) * kaw[1])};
      *(f32x2*)(st + 4 * 64 + 2 * cp) = (f32x2){x[0][0], x[0][1]};
      if ((cp >> 3) == part) *(f32x2*)(st + 5 * 64 + 2 * (cp & 7)) = (f32x2){x[2][0], x[2][1]};
    }
  };
  auto flush = [&](int chunk, const float* yb) {
    const int j = lt >> 3, pr = lt & 7; const int s = chunk * SC_CH + j; int pos, seqlen; const int row = scan_row(s, dir, b, pos, seqlen);
    *(unsigned*)(Y + (size_t)row * 1024 + hd * 64 + 16 * part + 2 * pr) = pk2(yb[j * 16 + 2 * pr], yb[j * 16 + 2 * pr + 1]);
  };
  __syncthreads();
  if (loader) { issue(0); process(0, bufs); issue(1); }
  __syncthreads();
  f32x4 S = {0.f, 0.f, 0.f, 0.f};
  const int rr = c.lane >> 4, ll = c.lane & 15;
  for (int ch = 0; ch < SC_NCHUNK; ++ch) {
    float* buf = bufs + (ch & 1) * SC_BUF_F;
    if (!loader) {
      float* yb = ybuf + (ch & 1) * (SC_CH * 16);
      const float* st = buf + 4 * ll; const float* vp = buf + 5 * 64 + 4 * c.wave + rr;
#pragma unroll 4
      for (int j = 0; j < SC_CH; ++j) {
        const f32x4 a = *(const f32x4*)(st + j * SC_STEP_F), wv = *(const f32x4*)(st + j * SC_STEP_F + 64), bv = *(const f32x4*)(st + j * SC_STEP_F + 128),
                    kd = *(const f32x4*)(st + j * SC_STEP_F + 192), rv = *(const f32x4*)(st + j * SC_STEP_F + 256);
        const float vv = vp[j * SC_STEP_F];
        float sa = (S[0] * a[0] + S[1] * a[1]) + (S[2] * a[2] + S[3] * a[3]);
        sa = ar16(sa);
        S = S * wv + (bv * sa + kd * vv);
        float y = (S[0] * rv[0] + S[1] * rv[1]) + (S[2] * rv[2] + S[3] * rv[3]);
        y = ar16(y);
        if (ll == 0) yb[j * 16 + 4 * c.wave + rr] = y;
      }
    } else {
      if (ch + 1 < SC_NCHUNK) process(ch + 1, bufs + ((ch + 1) & 1) * SC_BUF_F);
      if (ch + 2 < SC_NCHUNK) issue(ch + 2);
      if (ch > 0) flush(ch - 1, ybuf + ((ch - 1) & 1) * (SC_CH * 16));
    }
    __syncthreads();
  }
  if (loader) flush(SC_NCHUNK - 1, ybuf + ((SC_NCHUNK - 1) & 1) * (SC_CH * 16));
  __syncthreads();
}
#if !defined(NO_GEMM) && (!defined(GEMM_ONLY) || GEMM_ONLY == 0)
#define GEMMCALL0(a,b,c,d) pg8::gemm_phase(a,b,c,d)
#else
#define GEMMCALL0(a,b,c,d) (void)0
#endif
#if !defined(NO_GEMM) && (!defined(GEMM_ONLY) || GEMM_ONLY == 1)
#define GEMMCALL1(a,b,c,d) pg8::gemm_phase(a,b,c,d)
#else
#define GEMMCALL1(a,b,c,d) (void)0
#endif
#if !defined(NO_GEMM) && (!defined(GEMM_ONLY) || GEMM_ONLY == 2)
#define GEMMCALL2(a,b,c,d) pg8::gemm_phase(a,b,c,d)
#else
#define GEMMCALL2(a,b,c,d) (void)0
#endif
#if !defined(NO_GEMM) && (!defined(GEMM_ONLY) || GEMM_ONLY == 3)
#define GEMMCALL3(a,b,c,d) pg8::gemm_phase(a,b,c,d)
#else
#define GEMMCALL3(a,b,c,d) (void)0
#endif
#if !defined(NO_GEMM) && (!defined(GEMM_ONLY) || GEMM_ONLY == 4)
#define GEMMCALL4(a,b,c,d) pg8::gemm_phase(a,b,c,d)
#else
#define GEMMCALL4(a,b,c,d) (void)0
#endif
#if !defined(NO_GEMM) && (!defined(GEMM_ONLY) || GEMM_ONLY == 5)
#define GEMMCALL5(a,b,c,d) pg8::gemm_phase(a,b,c,d)
#else
#define GEMMCALL5(a,b,c,d) (void)0
#endif
#if !defined(NO_GEMM) && (!defined(GEMM_ONLY) || GEMM_ONLY == 6)
#define GEMMCALL6(a,b,c,d) pg8::gemm_phase(a,b,c,d)
#else
#define GEMMCALL6(a,b,c,d) (void)0
#endif
#if !defined(NO_GEMM) && (!defined(GEMM_ONLY) || GEMM_ONLY == 7)
#define GEMMCALL7(a,b,c,d) pg8::gemm_phase(a,b,c,d)
#else
#define GEMMCALL7(a,b,c,d) (void)0
#endif
#if !defined(NO_GEMM) && (!defined(GEMM_ONLY) || GEMM_ONLY == 8)
#define GEMMCALL8(a,b,c,d) pg8::gemm_phase(a,b,c,d)
#else
#define GEMMCALL8(a,b,c,d) (void)0
#endif
#define FRESH() do { int t_ = threadIdx.x; asm volatile("" : "+v"(t_)); c.tid = t_; c.lane = t_ & 63; c.wave = __builtin_amdgcn_readfirstlane(t_ >> 6); int b_ = blockIdx.x; asm volatile("" : "+s"(b_)); c.bid = b_; p = p0; asm volatile("" : "+s"(p)); ws = p->ws; } while (0)
#define mod_all ((float*)(ws + WS_MOD))
#define xc ((float*)(ws + WS_XC))
#define H ((bf16_t*)(ws + WS_H))
template <int l>
DI void layer_body(Ctx& c, const PP p0, cg::grid_group& grid, LAS unsigned char* ldsl) {
  PP p = p0; unsigned char* ws = p->ws;
    const float* xLin = l == 0 ? p->in[0] : p->out; const float* xCin = l == 0 ? p->in[2] : xc;
    const float* mod = mod_all + (size_t)l * 3 * 6144;
#ifndef NO_SMALL
    FRESH(); if (l > 0) phase_convert(c, p, l);
    FRESH(); phase_norm(c, p, xLin, xCin, p->in[6] + (size_t)l * 1024, mod, 0);
#endif
    grid.sync();
    { pg8::Gemm g{H, (const bf16_t*)(ws + WS_WIN), NTOK, 11008, 1024, 1024, 1024}; FRESH(); pg8::StaticOrder S; S.init(NTOK, 11008, c.nb, c.bid); pg8::EpiIn E{ws}; GEMMCALL0(ldsl, g, S, E); }
    { pg8::Gemm g{(const bf16_t*)(ws + WS_WV), H, 256, NTOK, 1024, 1024, 1024}; FRESH(); pg8::StaticOrder S; S.init(256, NTOK, c.nb, c.bid); pg8::EpiPlain E{(bf16_t*)(ws + WS_VT), NTOK}; GEMMCALL1(ldsl, g, S, E); }
    grid.sync();
    { pg8::Gemm g{(const bf16_t*)(ws + WS_LACT), (const bf16_t*)(ws + WS_WLORA), NTOK, 5120, 384, 512, 384}; FRESH(); pg8::StaticOrder S; S.init(NTOK, 5120, c.nb, c.bid);
      pg8::EpiLora E{ws, p->in[11] + (size_t)l * 2048, p->in[13] + (size_t)l * 2048}; GEMMCALL2(ldsl, g, S, E); }
    grid.sync();
    { const int nunits = (l == DEPTH - 1) ? 512 : 528;
#ifndef NO_ATTN
      FRESH(); for (int u = c.bid; u < nunits; u += c.nb) attn_unit(c, p, l, u);
#endif
#ifndef NO_CONVA
      FRESH(); phase_conv_a(c, p, l);
#endif
#ifndef NO_SCAN
      FRESH(); phase_scan(c, p, l);
#endif
    }
    grid.sync();
#ifndef NO_FIN
    FRESH(); phase_rwkv_fin(c, p, l);
#endif
    grid.sync();
    { FRESH(); pg8::StaticOrder S; S.init(NTOK, 1024, c.nb, c.bid);
      { pg8::Gemm g{(const bf16_t*)(ws + WS_AB), (const bf16_t*)(ws + WS_WA), NTOK, 1024, 1024, 1024, 1024}; pg8::EpiMerge<0> E{ws}; GEMMCALL3(ldsl, g, S, E); }
      { pg8::Gemm g{(const bf16_t*)(ws + WS_H), (const bf16_t*)(ws + WS_WA + AL((size_t)1024 * 1024 * 2)), NTOK, 1024, 1024, 1024, 1024}; pg8::EpiMerge<1> E{ws}; GEMMCALL4(ldsl, g, S, E); }
      { pg8::Gemm g{(const bf16_t*)(ws + WS_Q), (const bf16_t*)(ws + WS_WA + 2 * AL((size_t)1024 * 1024 * 2)), NTOK, 1024, 1024, 1024, 1024}; pg8::EpiMerge<2> E{ws}; GEMMCALL5(ldsl, g, S, E); } }
    grid.sync();
    { pg8::Gemm g{(const bf16_t*)(ws + WS_YB2), (const bf16_t*)(ws + WS_WA + 3 * AL((size_t)1024 * 1024 * 2)), NTOK, 1024, 1024, 1024, 1024}; FRESH(); pg8::StaticOrder S; S.init(NTOK, 1024, c.nb, c.bid);
      pg8::EpiRes E{xLin, xCin, p->out, xc, mod + 2 * 1024}; GEMMCALL6(ldsl, g, S, E); }
    grid.sync();
    FRESH(); phase_norm(c, p, p->out, xc, p->in[25] + (size_t)l * 1024, mod, 3);
    grid.sync();
    { pg8::Gemm g{H, (const bf16_t*)(ws + WS_WUP), NTOK, 5632, 1024, 1024, 1024}; FRESH(); pg8::StaticOrder S; S.init(NTOK, 5632, c.nb, c.bid); pg8::EpiPlain E{(bf16_t*)(ws + WS_U), 5632}; GEMMCALL7(ldsl, g, S, E); }
    grid.sync();
#ifndef NO_FFNACT
    FRESH(); phase_ffn_act(c, p, l);
#endif
    grid.sync();
    { pg8::Gemm g{(const bf16_t*)(ws + WS_GATES), (const bf16_t*)(ws + WS_WDN), NTOK, 1024, 2816, 2816, 2816}; FRESH(); pg8::StaticOrder S; S.init(NTOK, 1024, c.nb, c.bid);
      pg8::EpiRes E{p->out, xc, p->out, xc, mod + 5 * 1024}; GEMMCALL8(ldsl, g, S, E); }
    grid.sync();
  }

__global__ void __launch_bounds__(NTHR, 2) mega(Params pv) {
  extern __shared__ __attribute__((aligned(16))) unsigned char lds[];
  cg::grid_group grid = cg::this_grid();
  const PP p0 = (PP)__builtin_amdgcn_kernarg_segment_ptr(); PP p = p0;
  Ctx c; c.tid = threadIdx.x; c.lane = c.tid & 63; c.wave = __builtin_amdgcn_readfirstlane(c.tid >> 6); c.bid = blockIdx.x; c.nb = gridDim.x; c.lds = lds;
  LAS unsigned char* ldsl = (LAS unsigned char*)lds;
  unsigned char* ws = p->ws;
  FRESH(); phase_mods(c, p);
  FRESH(); phase_convert(c, p, 0);
  grid.sync();
  layer_body<0>(c, p0, grid, ldsl);
  layer_body<1>(c, p0, grid, ldsl);
  layer_body<2>(c, p0, grid, ldsl);
  layer_body<3>(c, p0, grid, ldsl);
  FRESH(); phase_final(c, p);
}

extern "C" void kernel_launch(void* const* d_in, const int* in_sizes, int n_in, void* d_out, int out_size, void* d_ws, size_t ws_size, hipStream_t stream) {
  static int grid = 0;
  if (grid == 0) {
    int dev = 0, cus = 0, per_cu = 0;
    (void)hipGetDevice(&dev); (void)hipDeviceGetAttribute(&cus, hipDeviceAttributeMultiprocessorCount, dev);
    (void)hipFuncSetAttribute((const void*)mega, hipFuncAttributeMaxDynamicSharedMemorySize, LDS_BYTES);
    (void)hipOccupancyMaxActiveBlocksPerMultiprocessor(&per_cu, (const void*)mega, NTHR, LDS_BYTES);
    grid = cus < 256 ? cus : 256;
    if (n_in != 30 || ws_size < WS_END || per_cu < 1) { fprintf(stderr, "kernel_launch: n_in %d ws %zu need %zu per_cu %d\n", n_in, ws_size, (size_t)WS_END, per_cu); if (n_in != 30 || ws_size < WS_END) grid = -1; }
  }
  if (grid < 0) return;
  Params p{};
  for (int i = 0; i < 30; ++i) p.in[i] = (const float*)d_in[i];
  p.out = (float*)d_out; p.ws = (unsigned char*)d_ws;
  void* args[] = {&p};
  hipError_t e = hipLaunchCooperativeKernel((const void*)mega, dim3(grid), dim3(NTHR), args, LDS_BYTES, stream);
  if (e != hipSuccess) fprintf(stderr, "cooperative launch failed: %s (grid %d)\n", hipGetErrorString(e), grid);
}
```

```cpp
#include <hip/hip_runtime.h>
#include <hip/hip_cooperative_groups.h>
#include <cstdio>
namespace cg = cooperative_groups;

#define LAS __attribute__((address_space(3)))
#define DI __device__ __forceinline__
typedef unsigned short bf16_t;
typedef short bf16x8 __attribute__((ext_vector_type(8)));
typedef short s16x4 __attribute__((ext_vector_type(4)));
typedef float f32x2 __attribute__((ext_vector_type(2)));
typedef float f32x4 __attribute__((ext_vector_type(4)));
typedef float f32x16 __attribute__((ext_vector_type(16)));
typedef unsigned u32x2 __attribute__((ext_vector_type(2)));
typedef unsigned u32x4 __attribute__((ext_vector_type(4)));
typedef __bf16 bf16x2_t __attribute__((ext_vector_type(2)));

constexpr int DM = 1024, NB = 2, SEQ = 8192, DEPTH = 4, CTXL = 256;
constexpr int NTL = NB * SEQ;
constexpr int NTC = NB * CTXL;
constexpr int NTOK = NTL + NTC;
constexpr int NIN = 11136, DFF = 2816;
constexpr int NTHR = 512;
constexpr int LDS_BAR_OFF = 135168;
constexpr int LDS_BYTES = LDS_BAR_OFF + 64;

constexpr size_t AL(size_t x) { return (x + 255) & ~(size_t)255; }
constexpr size_t SZ16 = (size_t)NTOK * 1024 * 2;
constexpr size_t WS_BAR   = 0;
constexpr size_t WS_MOD   = 32768;
constexpr size_t WS_ROPE  = WS_MOD + AL((size_t)DEPTH * 3 * 6144 * 4);
constexpr size_t WS_XC    = WS_ROPE + AL(128 * 16 * 2 * 4);
constexpr size_t WS_WIN   = WS_XC + AL((size_t)NTC * 1024 * 4);
constexpr size_t WS_WV    = WS_WIN + AL((size_t)11008 * 1024 * 2);
constexpr size_t WS_WLORA = WS_WV + AL((size_t)256 * 1024 * 2);
constexpr size_t WS_WA    = WS_WLORA + AL((size_t)5120 * 384 * 2);
constexpr size_t WS_WUP   = WS_WA + 4 * AL((size_t)1024 * 1024 * 2);
constexpr size_t WS_WDN   = WS_WUP + AL((size_t)5632 * 1024 * 2);
constexpr size_t WS_H     = WS_WDN + AL((size_t)1024 * 2816 * 2);
constexpr size_t WS_AB    = WS_H + SZ16;
constexpr size_t WS_AC    = WS_AB + SZ16;
constexpr size_t WS_AX    = WS_AC + SZ16;
constexpr size_t WS_RKV   = WS_AX + SZ16;
constexpr size_t WS_LACT  = WS_RKV + 3 * SZ16;
constexpr size_t WS_Q     = WS_LACT + SZ16 / 2;
constexpr size_t WS_K     = WS_Q + SZ16;
constexpr size_t WS_VT    = WS_K + SZ16 / 4;
constexpr size_t WS_GATES = WS_VT + SZ16 / 4;
constexpr size_t WS_LOUT  = WS_GATES + 3 * SZ16;
constexpr size_t WS_YB2   = WS_LOUT + 5 * SZ16;
constexpr size_t WS_CPART = WS_YB2 + SZ16;
constexpr size_t WS_END   = WS_CPART + (size_t)4 * NTC * 1024 * 4;
constexpr size_t WS_U     = WS_AB;
static_assert((size_t)NTOK * 5632 * 2 <= 6 * SZ16, "u alias");
static_assert(WS_END <= (size_t)729 * 1000 * 1000, "workspace");

struct Params {
  const float* in[30];
  float* out;
  unsigned char* ws;
};

typedef const __attribute__((address_space(4))) Params* PP;
DI float bf2f(unsigned v) { return __uint_as_float(v << 16); }
DI float bflo(unsigned v) { return __uint_as_float(v << 16); }
DI float bfhi(unsigned v) { return __uint_as_float(v & 0xffff0000u); }
DI unsigned pk2(float a, float b) { f32x2 v = {a, b}; bf16x2_t r = __builtin_convertvector(v, bf16x2_t); return __builtin_bit_cast(unsigned, r); }
DI void unpack8(const u32x4 w, float (&f)[8]) { f[0] = bflo(w.x); f[1] = bfhi(w.x); f[2] = bflo(w.y); f[3] = bfhi(w.y); f[4] = bflo(w.z); f[5] = bfhi(w.z); f[6] = bflo(w.w); f[7] = bfhi(w.w); }
DI float sigmoidf_(float x) { return __builtin_amdgcn_rcpf(1.0f + __builtin_amdgcn_exp2f(-1.4426950408889634f * x)); }
DI float wave_sum(float v) {
#pragma unroll
  for (int o = 32; o >= 1; o >>= 1) v += __shfl_xor(v, o);
  return v;
}
DI float ar16(float x) {
  x += __builtin_bit_cast(float, __builtin_amdgcn_update_dpp(0, __builtin_bit_cast(int, x), 0x128, 0xf, 0xf, false));
  x += __builtin_bit_cast(float, __builtin_amdgcn_update_dpp(0, __builtin_bit_cast(int, x), 0x124, 0xf, 0xf, false));
  x += __builtin_bit_cast(float, __builtin_amdgcn_update_dpp(0, __builtin_bit_cast(int, x), 0x122, 0xf, 0xf, false));
  x += __builtin_bit_cast(float, __builtin_amdgcn_update_dpp(0, __builtin_bit_cast(int, x), 0x121, 0xf, 0xf, false));
  return x;
}

#define XB_TMO      128
#define XB_XCNT(j)  (256  + 64 * (j))
#define XB_XSUB(j)  (1280 + 64 * (j))
#define XB_XGEN(j)  (2304 + 64 * (j))
#define XB_TOP      3328
#define XB_TOPGEN   3392
#define XCD_BAR_WORDS 3456
#define XB_SPIN_CAP (1u << 22)
DI unsigned xb_ld(unsigned* p)              { return __hip_atomic_load(p, __ATOMIC_RELAXED, __HIP_MEMORY_SCOPE_AGENT); }
DI unsigned xb_add(unsigned* p, unsigned v) { return __hip_atomic_fetch_add(p, v, __ATOMIC_RELAXED, __HIP_MEMORY_SCOPE_AGENT); }
DI unsigned xb_xcc_id() { return (unsigned)__builtin_amdgcn_s_getreg((3 << 11) | 20) & 0xFu; }
#define XB_SPIN(cond, bar) do { unsigned _sp = 0; while (cond) { __builtin_amdgcn_s_sleep(1); \
    if ((++_sp & 255u) == 0u) { if (xb_ld(&(bar)[XB_TMO])) break; if (_sp > XB_SPIN_CAP) { atomicAdd(&(bar)[XB_TMO], 1u); break; } } } } while (0)
DI void xcd_barrier_complete(unsigned* bar, unsigned x, unsigned& nloc, unsigned& nx) {
  const unsigned G = gridDim.x;
  unsigned sum, cnt, mine, sp = 0u;
  for (;;) {
    sum = 0u; cnt = 0u; mine = 0u;
#pragma unroll
    for (unsigned j = 0; j < 16; ++j) { const unsigned c = xb_ld(&bar[XB_XCNT(j)]); sum += c; cnt += (c > 0u) ? 1u : 0u; mine = (j == x) ? c : mine; }
    if (sum == G) break;
    __builtin_amdgcn_s_sleep(1);
    if ((++sp & 255u) == 0u) { if (xb_ld(&bar[XB_TMO])) break; if (sp > XB_SPIN_CAP) { atomicAdd(&bar[XB_TMO], 1u); break; } }
  }
  nloc = mine > 0u ? mine : 1u; nx = cnt > 0u ? cnt : 1u;
}
DI void xcd_barrier(unsigned* bar, volatile LAS unsigned* st) {
  asm volatile("s_waitcnt vmcnt(0)" ::: "memory");
  __syncthreads();
  if (threadIdx.x == 0) {
    const unsigned x = xb_xcc_id();
    __builtin_amdgcn_s_waitcnt(0);
    unsigned nloc = st[0], nx = st[1];
    if (nloc == 0u) { xcd_barrier_complete(bar, x, nloc, nx); st[0] = nloc; st[1] = nx; }
    const unsigned old = xb_add(&bar[XB_XSUB(x)], 1u);
    const unsigned gen = old / nloc;
    if (old + 1u == (gen + 1u) * nloc) {
      __builtin_amdgcn_fence(__ATOMIC_RELEASE, "agent");
      asm volatile("s_waitcnt vmcnt(0)" ::: "memory");
      const unsigned og = xb_add(&bar[XB_TOP], 1u);
      const unsigned tg = og / nx;
      if (og + 1u == (tg + 1u) * nx) xb_add(&bar[XB_TOPGEN], 1u);
      else XB_SPIN(xb_ld(&bar[XB_TOPGEN]) == tg, bar);
      __builtin_amdgcn_fence(__ATOMIC_ACQUIRE, "agent");
      xb_add(&bar[XB_XGEN(x)], 1u);
      asm volatile("s_waitcnt vmcnt(0)" ::: "memory");
    } else {
      XB_SPIN(xb_ld(&bar[XB_XGEN(x)]) == gen, bar);
      __builtin_amdgcn_fence(__ATOMIC_ACQUIRE, "agent");
      asm volatile("s_waitcnt vmcnt(0)" ::: "memory");
    }
  }
  __syncthreads();
}
namespace pg8 {
constexpr int BM = 256, BK = 64, HALF = 128, HTB = HALF * BK * 2, NXCD = 8, WGM = 8;
DI int lds_byte(int r, int c) { const int st = (r >> 4) * 2 + (c >> 5), rr = r & 15, cc = c & 31, ob = rr * 64 + cc * 2; return st * 1024 + (ob ^ (((ob >> 9) & 1) << 5)); }
DI void stage_rc(int b, int& R, int& C) { const int st = b / 1024, sb = b % 1024, swz = sb ^ (((sb >> 9) & 1) << 5); R = (st >> 1) * 16 + swz / 64; C = (st & 1) * 32 + (swz % 64) / 2; }
DI int perm32(int rho) { const int n = rho >> 4, i = rho & 15; return 8 * (i >> 2) + 4 * n + (i & 3); }
struct Unit { int pm, pn, which, kt0, nkt; };
struct Gemm { const bf16_t* A; const bf16_t* Bt; int M, N, K, lda, ldb; const bf16_t* A2; const bf16_t* Bt2; const bf16_t* A3; const bf16_t* Bt3; };
struct StaticOrder {
  int nM, nN, nwg, G, c, nwg2;
  DI void init(int M, int N, int G_, int c_, int n2 = 0) { nM = M / BM; nN = N / BM; nwg = nM * nN; G = G_; c = c_; nwg2 = n2; }
  DI bool next(int i, Unit& u) const {
    const long L = (long)i * G + c; u.which = 0; u.kt0 = 0; u.nkt = 0;
    if (L >= nwg) { if (L >= nwg + nwg2) return false; u.which = 1; u.pm = 0; u.pn = (int)L - nwg; return true; }
    int wgid = (int)L; { const int q = nwg / NXCD, r = nwg % NXCD, xcd = wgid % NXCD, off = wgid / NXCD; wgid = (xcd < r ? xcd * (q + 1) : r * (q + 1) + (xcd - r) * q) + off; }
    const int nig = WGM * nN, gid = wgid / nig, fm = gid * WGM, gsz = (nM - fm) < WGM ? (nM - fm) : WGM;
    u.pm = fm + ((wgid % nig) % gsz); u.pn = (wgid % nig) / gsz; return true;
  }
};

template <class Epi, class Sched>
DI void gemm_phase(LAS unsigned char* lds, const Gemm g, const Sched& S, const Epi& E) {
  int tid = threadIdx.x; asm volatile("" : "+v"(tid));
  const int wid = __builtin_amdgcn_readfirstlane(tid >> 6), lane = tid & 63, wr = wid >> 2, wc = wid & 3, fr = lane & 15, fq = lane >> 4;
  const int K = g.K, nt = K / BK;
  unsigned voffA[2], voffB[2];
#pragma unroll
  for (int i = 0; i < 2; ++i) { int R, C; stage_rc(tid * 16 + i * 8192, R, C); const int Rb = Epi::PERM ? ((R & ~31) + perm32(R & 31)) : R;
    voffA[i] = (unsigned)(R * g.lda + C) * 2u; voffB[i] = (unsigned)(Rb * g.ldb + C) * 2u; }
  const size_t kstep = (size_t)(BK * 2);
  const size_t hstepA = (size_t)HALF * g.lda * 2, hstepB = (size_t)HALF * g.ldb * 2;
  const size_t tstepA = 2 * hstepA, tstepB = 2 * hstepB;
  const unsigned ldsw = (unsigned)wid * 1024u;
#define PG8_SA(b, h) (((b) * 2 + (h)) * HTB)
#define PG8_SB(b, h) ((4 + (b) * 2 + (h)) * HTB)
#define PG8_STAGE(bufoff, gbase, voff) do { _Pragma("unroll") for (int _i = 0; _i < 2; ++_i) \
    __builtin_amdgcn_global_load_lds((const unsigned*)((const char*)(gbase) + (voff)[_i]), (LAS unsigned*)(lds + (bufoff) + ldsw + _i * 8192), 16, 0, 0); } while (0)
#define PG8_LDA(dst, b, h) do { _Pragma("unroll") for (int m = 0; m < 4; ++m) _Pragma("unroll") for (int k = 0; k < 2; ++k) dst[m][k] = *(const LAS bf16x8*)(lds + PG8_SA(b, h) + aoff + m * 2048 + k * 1024); } while (0)
#define PG8_LDB(dst, b, h) do { _Pragma("unroll") for (int n = 0; n < 2; ++n) _Pragma("unroll") for (int k = 0; k < 2; ++k) dst[n][k] = *(const LAS bf16x8*)(lds + PG8_SB(b, h) + boff + n * 2048 + k * 1024); } while (0)
#define PG8_MMA(ai, bj, At, Bt) do { __builtin_amdgcn_s_setprio(1); _Pragma("unroll") for (int m = 0; m < 4; ++m) _Pragma("unroll") for (int n = 0; n < 2; ++n) _Pragma("unroll") for (int k = 0; k < 2; ++k) \
    acc[ai][bj][m][n] = __builtin_amdgcn_mfma_f32_16x16x32_bf16(Bt[n][k], At[m][k], acc[ai][bj][m][n], 0, 0, 0); __builtin_amdgcn_s_setprio(0); } while (0)
#define PG8_WAIT_V(n) asm volatile("s_waitcnt vmcnt(" #n ")" ::: "memory")
#define PG8_WAIT_L(n) asm volatile("s_waitcnt lgkmcnt(" #n ")" ::: "memory")
#define PG8_BAR __builtin_amdgcn_s_barrier()
#define PG8_SCHED __builtin_amdgcn_sched_barrier(0)
  Unit cur, nxt; int ui = 0;
  if (!S.next(0, cur)) return;
  f32x4 acc[2][2][4][2];
#pragma unroll
  for (int a = 0; a < 2; ++a)
#pragma unroll
    for (int b = 0; b < 2; ++b)
#pragma unroll
      for (int m = 0; m < 4; ++m)
#pragma unroll
        for (int n = 0; n < 2; ++n) acc[a][b][m][n] = (f32x4){0.f, 0.f, 0.f, 0.f};
  bf16x8 At[4][2], B0[2][2], B1[2][2];
  const char* cA = (const char*)(cur.which == 0 ? g.A : (cur.which == 1 ? g.A2 : g.A3)) + (size_t)cur.pm * tstepA + (size_t)cur.kt0 * kstep; const char* cB = (const char*)(cur.which == 0 ? g.Bt : (cur.which == 1 ? g.Bt2 : g.Bt3)) + (size_t)cur.pn * tstepB + (size_t)cur.kt0 * kstep;
  PG8_STAGE(PG8_SB(0, 0), cB, voffB); PG8_STAGE(PG8_SA(0, 0), cA, voffA); PG8_STAGE(PG8_SB(0, 1), cB + hstepB, voffB); PG8_STAGE(PG8_SA(0, 1), cA + hstepA, voffA);
  if (wr == 1) PG8_BAR;
  PG8_WAIT_V(4); PG8_BAR;
  PG8_STAGE(PG8_SB(1, 0), cB + kstep, voffB); PG8_STAGE(PG8_SA(1, 0), cA + kstep, voffA); PG8_STAGE(PG8_SB(1, 1), cB + hstepB + kstep, voffB);
  PG8_WAIT_V(6); PG8_BAR;
  for (;;) {
    int t3 = threadIdx.x; asm volatile("" : "+v"(t3));
    const int aoff = lds_byte(wr * 64 + (t3 & 15), ((t3 & 63) >> 4) * 8), boff = lds_byte(wc * 32 + (t3 & 15), ((t3 & 63) >> 4) * 8);
    const bool has_next = S.next(ui + 1, nxt);
    const char* nA = has_next ? (const char*)(nxt.which == 0 ? g.A : (nxt.which == 1 ? g.A2 : g.A3)) + (size_t)nxt.pm * tstepA + (size_t)nxt.kt0 * kstep : cA; const char* nB = has_next ? (const char*)(nxt.which == 0 ? g.Bt : (nxt.which == 1 ? g.Bt2 : g.Bt3)) + (size_t)nxt.pn * tstepB + (size_t)nxt.kt0 * kstep : cB;
    const int ntu = cur.nkt > 0 ? cur.nkt : nt;
    for (int t = 0; t < ntu; t += 2) {
      const bool last = (t == ntu - 2);
      const char* a1 = cA + (size_t)(t + 1) * kstep;
      const char* a2 = last ? nA : cA + (size_t)(t + 2) * kstep; const char* b2 = last ? nB : cB + (size_t)(t + 2) * kstep;
      const char* a3 = a2 + kstep; const char* b3 = b2 + kstep;
      PG8_LDB(B0, 0, 0); PG8_SCHED; PG8_LDA(At, 0, 0); PG8_STAGE(PG8_SA(1, 1), a1 + hstepA, voffA);
      PG8_WAIT_L(8); PG8_BAR; PG8_WAIT_L(0); PG8_MMA(0, 0, At, B0); PG8_BAR; PG8_SCHED;
      PG8_LDB(B1, 0, 1); PG8_STAGE(PG8_SB(0, 0), b2, voffB);
      PG8_BAR; PG8_WAIT_L(0); PG8_MMA(0, 1, At, B1); PG8_BAR;
      PG8_LDA(At, 0, 1); PG8_STAGE(PG8_SA(0, 0), a2, voffA);
      PG8_BAR; PG8_WAIT_L(0); PG8_MMA(1, 0, At, B0); PG8_BAR; PG8_SCHED;
      PG8_STAGE(PG8_SB(0, 1), b2 + hstepB, voffB);
      PG8_WAIT_V(6); PG8_BAR; PG8_MMA(1, 1, At, B1); PG8_BAR;
      PG8_LDB(B0, 1, 0); PG8_SCHED; PG8_LDA(At, 1, 0); PG8_STAGE(PG8_SA(0, 1), a2 + hstepA, voffA);
      PG8_WAIT_L(8); PG8_BAR; PG8_WAIT_L(0); PG8_MMA(0, 0, At, B0); PG8_BAR; PG8_SCHED;
      PG8_LDB(B1, 1, 1); PG8_STAGE(PG8_SB(1, 0), b3, voffB);
      PG8_BAR; PG8_WAIT_L(0); PG8_MMA(0, 1, At, B1); PG8_BAR;
      PG8_LDA(At, 1, 1); PG8_STAGE(PG8_SA(1, 0), a3, voffA);
      PG8_BAR; PG8_WAIT_L(0); PG8_MMA(1, 0, At, B0); PG8_BAR; PG8_SCHED;
      PG8_STAGE(PG8_SB(1, 1), b3 + hstepB, voffB);
      PG8_WAIT_V(6); PG8_BAR; PG8_MMA(1, 1, At, B1); PG8_BAR;
    }
    { int t2 = threadIdx.x; asm volatile("" : "+v"(t2)); const int w2 = __builtin_amdgcn_readfirstlane(t2 >> 6), l2 = t2 & 63; E(acc, cur, w2 >> 2, w2 & 3, l2 & 15, l2 >> 4); }
    if (!has_next) break;
    if (!Epi::CHAIN || nxt.which == 0 || nxt.pm >= 64) {
#pragma unroll
    for (int a = 0; a < 2; ++a)
#pragma unroll
      for (int b = 0; b < 2; ++b)
#pragma unroll
        for (int m = 0; m < 4; ++m)
#pragma unroll
          for (int n = 0; n < 2; ++n) acc[a][b][m][n] = (f32x4){0.f, 0.f, 0.f, 0.f};
    }
    cur = nxt; cA = nA; cB = nB; ++ui;
  }
  PG8_WAIT_V(0);
  if (wr == 0) PG8_BAR;
  PG8_BAR;
#undef PG8_SA
#undef PG8_SB
#undef PG8_STAGE
#undef PG8_LDA
#undef PG8_LDB
#undef PG8_MMA
#undef PG8_WAIT_V
#undef PG8_WAIT_L
#undef PG8_BAR
#undef PG8_SCHED
}
typedef f32x4 Acc[2][2][4][2];

template <class F>
DI void store_perm(const f32x4 (&acc)[2][2][4][2], bf16_t* O, int ldc, int rowt, int colt, int wr, int wc, int fr, int fq, const F& f, bool skip_bj1) {
  const int row0 = rowt + wr * 64 + fr, col0 = colt + wc * 32 + 8 * fq;
#pragma unroll
  for (int ai = 0; ai < 2; ++ai)
#pragma unroll
    for (int m = 0; m < 4; ++m) { bf16_t* rowp = O + (size_t)(row0 + ai * HALF + m * 16) * ldc + col0;
#pragma unroll
      for (int bj = 0; bj < 2; ++bj) { if (bj == 1 && skip_bj1) continue;
        const f32x4 v0 = acc[ai][bj][m][0], v1 = acc[ai][bj][m][1];
        u32x4 w; w.x = pk2(f(v0[0], bj, 0), f(v0[1], bj, 1)); w.y = pk2(f(v0[2], bj, 2), f(v0[3], bj, 3)); w.z = pk2(f(v1[0], bj, 4), f(v1[1], bj, 5)); w.w = pk2(f(v1[2], bj, 6), f(v1[3], bj, 7));
        *(u32x4*)(rowp + bj * HALF) = w; }
      asm volatile("" ::: "memory"); }
}

struct EpiPlain {
  static constexpr bool PERM = true, CHAIN = false;
  bf16_t* O; int ldc;
  DI void operator()(const f32x4 (&acc)[2][2][4][2], const Unit& u, int wr, int wc, int fr, int fq) const {
    store_perm(acc, O, ldc, u.pm * BM, u.pn * BM, wr, wc, fr, fq, [](float v, int, int) { return v; }, false);
  }
};
struct EpiIn {
  static constexpr bool PERM = true, CHAIN = false;
  unsigned char* ws;
  DI void operator()(const f32x4 (&acc)[2][2][4][2], const Unit& u, int wr, int wc, int fr, int fq) const {
    const int pn = u.pn, rowt = u.pm * BM;
    size_t off; int ld, colt, act = 0;
    if (u.which) { off = WS_VT; ld = NTOK; colt = pn * 256; }
    else if (pn < 12) { off = pn < 4 ? WS_AB : pn < 8 ? WS_AC : WS_AX; ld = 1024; colt = (pn & 3) * 256; }
    else if (pn < 24) { off = WS_RKV; ld = 3072; colt = (pn - 12) * 256; }
    else if (pn == 24) { off = WS_LACT; ld = 512; colt = 0; act = 1; }
    else if (pn == 25) { off = WS_LACT; ld = 512; colt = 256; act = 2; }
    else if (pn < 30) { off = WS_Q; ld = 1024; colt = (pn - 26) * 256; }
    else if (pn == 30) { off = WS_K; ld = 256; colt = 0; }
    else { off = WS_GATES; ld = 3072; colt = (pn - 31) * 256; act = 3; }
    if (act == 0) store_perm(acc, (bf16_t*)(ws + off), ld, rowt, colt, wr, wc, fr, fq, [](float v, int, int) { return v; }, false);
    else store_perm(acc, (bf16_t*)(ws + off), ld, rowt, colt, wr, wc, fr, fq, [act](float v, int bj, int) { const bool th = act == 1 && bj == 0; const float sg = sigmoidf_(th ? 2.0f * v : v); return (act == 1 && bj == 1) ? v : (th ? 2.0f * sg - 1.0f : sg); }, act == 2);
  }
};
struct LoraOrder {
  StaticOrder S;
  DI bool next(int i, Unit& u) const { if (!S.next(i, u)) return false; const int grp = u.pn >> 2; u.kt0 = grp < 2 ? 0 : (grp < 4 ? 2 : 4); u.nkt = 2; return true; }
};
struct EpiLora {
  static constexpr bool PERM = true, CHAIN = false;
  unsigned char* ws; const float* w0; const float* a0;
  DI void operator()(const f32x4 (&acc)[2][2][4][2], const Unit& u, int wr, int wc, int fr, int fq) const {
    const int grp = u.pn >> 2, colt = (u.pn & 3) * 256, rowt = u.pm * BM;
    bf16_t* O = (bf16_t*)(ws + WS_LOUT + (size_t)grp * SZ16);
    const int cbase = colt + wc * 32 + 8 * fq;
    if (grp < 4) { const float* bp = (grp < 2 ? w0 + grp * 1024 : a0 + (grp - 2) * 1024) + cbase; const float sc = grp < 2 ? 0.60653066f : 1.0f;
      const f32x4 b00 = *(const f32x4*)bp, b01 = *(const f32x4*)(bp + 4), b10 = *(const f32x4*)(bp + HALF), b11 = *(const f32x4*)(bp + HALF + 4);
      store_perm(acc, O, 1024, rowt, colt, wr, wc, fr, fq, [=](float v, int bj, int j) { const float bb = bj ? (j < 4 ? b10[j & 3] : b11[j & 3]) : (j < 4 ? b00[j & 3] : b01[j & 3]); return sc * sigmoidf_(v + bb); }, false); }
    else store_perm(acc, O, 1024, rowt, colt, wr, wc, fr, fq, [](float v, int, int) { return v; }, false);
  }
};
struct MergeOrder {
  StaticOrder S; int nctx;
  DI bool next(int i, Unit& u) const {
    const int R = (S.nwg + S.G - 1) / S.G;
    if (i < 3 * R) { if (!S.next(i / 3, u)) return false; u.which = i % 3; return true; }
    const int e = (i - 3 * R) * S.G + S.c; if (e >= nctx) return false;
    const int tile = e / 3;
    u.pm = 64 + (tile >> 2); u.pn = tile & 3; u.which = e - 3 * tile; u.kt0 = 0; u.nkt = 0; return true;
  }
};
struct EpiMergeChain {
  static constexpr bool PERM = true, CHAIN = true;
  unsigned char* ws;
  DI void operator()(f32x4 (&acc)[2][2][4][2], const Unit& u, int wr, int wc, int fr, int fq) const {
    const int row0 = u.pm * BM + wr * 64 + fr, col0 = u.pn * BM + wc * 32 + 8 * fq, br = u.which;
    const bf16_t* G = (const bf16_t*)(ws + WS_GATES) + br * 1024; bf16_t* M16 = (bf16_t*)(ws + WS_YB2);
    const bool isctx = u.pm >= 64;
    float* MP = (float*)(ws + WS_CPART) + (size_t)br * NTC * 1024 - (size_t)NTL * 1024;
#pragma unroll
    for (int ai = 0; ai < 2; ++ai)
#pragma unroll
      for (int m = 0; m < 4; ++m) { const size_t row = (size_t)(row0 + ai * HALF + m * 16);
#pragma unroll
        for (int bj = 0; bj < 2; ++bj) { const int c = col0 + bj * HALF;
          float f[8]; unpack8(*(const u32x4*)(G + row * 3072 + c), f);
          if (br < 2 && !isctx) { float h[8]; unpack8(*(const u32x4*)(G + row * 3072 + 1024 + c), h);
#pragma unroll
            for (int j = 0; j < 8; ++j) f[j] *= __builtin_amdgcn_rcpf(h[j]); }
          acc[ai][bj][m][0] *= (f32x4){f[0], f[1], f[2], f[3]}; acc[ai][bj][m][1] *= (f32x4){f[4], f[5], f[6], f[7]};
          if (isctx) { float* q = MP + row * 1024 + c; *(f32x4*)q = acc[ai][bj][m][0]; *(f32x4*)(q + 4) = acc[ai][bj][m][1]; }
          else if (br == 2) { const f32x4 v0 = acc[ai][bj][m][0], v1 = acc[ai][bj][m][1]; u32x4 w; w.x = pk2(v0[0], v0[1]); w.y = pk2(v0[2], v0[3]); w.z = pk2(v1[0], v1[1]); w.w = pk2(v1[2], v1[3]);
            *(u32x4*)(M16 + row * 1024 + c) = w; } }
        asm volatile("" ::: "memory"); }
  }
};
struct ResOrder {
  StaticOrder S; int nsplit, ks, nktq;
  DI bool next(int i, Unit& u) const {
    const long L = (long)i * S.G + S.c;
    int pm, pn, which = 0, kt0 = 0, nkt = 0;
    if (L < S.nwg) {
      int wgid = (int)L; { const int q = S.nwg / NXCD, r = S.nwg % NXCD, xcd = wgid % NXCD, off = wgid / NXCD; wgid = (xcd < r ? xcd * (q + 1) : r * (q + 1) + (xcd - r) * q) + off; }
      const int nig = WGM * S.nN, gid = wgid / nig, fm = gid * WGM, gsz = (S.nM - fm) < WGM ? (S.nM - fm) : WGM;
      pm = fm + ((wgid % nig) % gsz); pn = (wgid % nig) / gsz;
    } else {
      const int e = (int)L - S.nwg; if (e >= nsplit) return false;
      const int tile = e / ks, part = e - tile * ks;
      pm = 64 + (tile >> 2); pn = tile & 3; which = 1; kt0 = part * nktq; nkt = nktq;
    }
    u.pm = pm; u.pn = pn; u.which = which; u.kt0 = kt0; u.nkt = nkt; return true;
  }
};
struct EpiRes {
  static constexpr bool PERM = true, CHAIN = false;
  const float* baseL; const float* baseC; float* outL; float* outC; const float* mod;
  float* cpart; int nktq;
  DI void operator()(const f32x4 (&acc)[2][2][4][2], const Unit& u, int wr, int wc, int fr, int fq) const {
    const bool isc = u.pm >= 64; const int r3 = u.pm < 32 ? 0 : (u.pm < 64 ? 1 : 2);
    const float* base = isc ? baseC - (size_t)NTL * 1024 : baseL; float* out = isc ? outC - (size_t)NTL * 1024 : outL;
    const int row0 = u.pm * BM + wr * 64 + fr, col0 = u.pn * BM + wc * 32 + 8 * fq;
    const float* mv = mod + r3 * 6144;
    f32x4 g[2][2];
#pragma unroll
    for (int bj = 0; bj < 2; ++bj)
#pragma unroll
      for (int n = 0; n < 2; ++n) g[bj][n] = *(const f32x4*)(mv + col0 + bj * HALF + 4 * n);
#pragma unroll
    for (int ai = 0; ai < 2; ++ai)
#pragma unroll
      for (int m = 0; m < 4; ++m) { const size_t off = (size_t)(row0 + ai * HALF + m * 16) * 1024;
#pragma unroll
        for (int bj = 0; bj < 2; ++bj)
#pragma unroll
          for (int n = 0; n < 2; ++n) { const int c = col0 + bj * HALF + 4 * n;
            const f32x4 v = g[bj][n] * acc[ai][bj][m][n];
            if (u.which) { *(f32x4*)(cpart + (size_t)(u.kt0 / nktq) * NTC * 1024 + (off - (size_t)NTL * 1024) + c) = v; }
            else { const f32x4 b = *(const f32x4*)(base + off + c); *(f32x4*)(out + off + c) = b + v; } }
        asm volatile("" ::: "memory"); }
  }
};
}
struct Ctx { int tid, lane, wave, bid, nb; unsigned char* lds; };

DI void conv_tile(const Ctx& c, bf16_t* dst, int ldd, const float* src, int ldsrc) {
  float* t = (float*)c.lds;
  if (src) {
#pragma unroll
    for (int i = 0; i < 8; ++i) { const int e = c.tid + i * NTHR, kk = e >> 6, nn = e & 63; t[kk * 65 + nn] = src[(size_t)kk * ldsrc + nn]; }
  }
  __syncthreads();
#pragma unroll
  for (int i = 0; i < 4; ++i) { const int e = c.tid + i * NTHR, nn = e >> 5, kp = e & 31;
    unsigned w = 0u; if (src) w = pk2(t[(2 * kp) * 65 + nn], t[(2 * kp + 1) * 65 + nn]);
    *(unsigned*)(dst + (size_t)nn * ldd + 2 * kp) = w; }
  __syncthreads();
}
DI void phase_convert(const Ctx& c, PP p, int l) {
  unsigned char* ws = p->ws;
  for (int t = c.bid; t < 6432; t += c.nb) {
    if (t < 2816) { const int nt = t >> 4, kt = t & 15; const int n0 = nt * 64, k0 = kt * 64;
      const float* W = p->in[7] + (size_t)l * 1024 * NIN;
      bf16_t* dst; int srccol;
      if (n0 < 6528) { dst = (bf16_t*)(ws + WS_WIN) + (size_t)n0 * 1024; srccol = n0; }
      else if (n0 < 6656) { dst = (bf16_t*)(ws + WS_WIN) + (size_t)n0 * 1024; srccol = -1; }
      else if (n0 < 7936) { dst = (bf16_t*)(ws + WS_WIN) + (size_t)n0 * 1024; srccol = n0 - 128; }
      else if (n0 < 11008) { dst = (bf16_t*)(ws + WS_WIN) + (size_t)n0 * 1024; srccol = n0 - 7936 + 8064; }
      else { dst = (bf16_t*)(ws + WS_WV) + (size_t)(n0 - 11008) * 1024; srccol = n0 - 11008 + 7808; }
      conv_tile(c, dst + k0, 1024, srccol < 0 ? nullptr : W + (size_t)k0 * NIN + srccol, NIN);
    } else if (t < 3296) { const int u = t - 2816, nt = u / 6, kt = u % 6; const int n0 = nt * 64, k0 = kt * 64, grp = n0 >> 10, nc = n0 & 1023;
      const float* src = nullptr;
      if (grp < 2) { if (kt == grp) src = p->in[12] + ((size_t)(l * 2 + grp) * 64) * 1024 + nc; }
      else if (grp < 4) { if (kt == grp) src = p->in[14] + ((size_t)(l * 2 + grp - 2) * 64) * 1024 + nc; }
      else { if (kt >= 4) src = p->in[15] + ((size_t)l * 128 + (kt - 4) * 64) * 1024 + nc; }
      conv_tile(c, (bf16_t*)(ws + WS_WLORA) + (size_t)n0 * 384 + k0, 384, src, 1024);
    } else if (t < 4320) { const int u = t - 3296, which = u >> 8, v = u & 255, nt = v >> 4, kt = v & 15;
      const int idx = which == 0 ? 9 : which == 1 ? 21 : which == 2 ? 23 : 24;
      const float* W = p->in[idx] + (size_t)l * 1024 * 1024;
      conv_tile(c, (bf16_t*)(ws + WS_WA + (size_t)which * AL((size_t)1024 * 1024 * 2)) + (size_t)(nt * 64) * 1024 + kt * 64, 1024, W + (size_t)(kt * 64) * 1024 + nt * 64, 1024);
    } else if (t < 5728) { const int u = t - 4320, nt = u >> 4, kt = u & 15;
      const float* W = p->in[26] + (size_t)l * 1024 * 5632;
      conv_tile(c, (bf16_t*)(ws + WS_WUP) + (size_t)(nt * 64) * 1024 + kt * 64, 1024, W + (size_t)(kt * 64) * 5632 + nt * 64, 5632);
    } else { const int u = t - 5728, nt = u / 44, kt = u % 44;
      const float* W = p->in[28] + (size_t)l * 2816 * 1024;
      conv_tile(c, (bf16_t*)(ws + WS_WDN) + (size_t)(nt * 64) * 2816 + kt * 64, 2816, W + (size_t)(kt * 64) * 1024 + nt * 64, 1024);
    }
  }
}

DI void phase_mods(const Ctx& c, PP p) {
  float* s = (float*)c.lds;
  float* red = s + 3 * 1024;
  for (int i = c.tid; i < 3072; i += NTHR) { const float v = i < 2048 ? p->in[1][i] : p->in[3][i - 2048]; s[i] = v * sigmoidf_(v); }
  __syncthreads();
  float* mod = (float*)(p->ws + WS_MOD);
  const int col = c.tid & 63, kg = c.tid >> 6;
  for (int it = c.bid; it < DEPTH * 96; it += c.nb) {
    const int l = it / 96, j0 = (it % 96) * 64;
    const float* W = p->in[4] + (size_t)l * 1024 * 6144 + j0 + col;
    float a0 = 0.f, a1 = 0.f, a2 = 0.f;
#pragma unroll 8
    for (int k = kg * 128; k < kg * 128 + 128; ++k) { const float w = W[(size_t)k * 6144]; a0 += s[k] * w; a1 += s[1024 + k] * w; a2 += s[2048 + k] * w; }
    red[(kg * 3 + 0) * 64 + col] = a0; red[(kg * 3 + 1) * 64 + col] = a1; red[(kg * 3 + 2) * 64 + col] = a2;
    __syncthreads();
    if (c.tid < 192) { const int r = c.tid >> 6; float v = p->in[5][(size_t)l * 6144 + j0 + col];
#pragma unroll
      for (int g = 0; g < 8; ++g) v += red[(g * 3 + r) * 64 + col];
      mod[((size_t)l * 3 + r) * 6144 + j0 + col] = v; }
    __syncthreads();
  }
  { float* xcd = (float*)(p->ws + WS_XC); const float* cx = p->in[2];
    for (int i = c.bid * NTHR + c.tid; i < NTC * 1024 / 4; i += c.nb * NTHR) ((f32x4*)xcd)[i] = ((const f32x4*)cx)[i]; }
  const int gt = c.bid * NTHR + c.tid;
  if (gt < 2048) { const int pos = gt >> 4, f = gt & 15; const float inv = powf(10000.0f, -(float)f / 16.0f); const float ang = (float)pos * inv;
    float* rope = (float*)(p->ws + WS_ROPE); rope[gt] = cosf(ang); rope[2048 + gt] = sinf(ang); }
}

DI void phase_norm(const Ctx& c, PP p, const float* xL, float* xC, const float* g, const float* mod  , int shift_idx, int npart) {
  const float* cpart = (const float*)(p->ws + WS_CPART);
  bf16_t* H = (bf16_t*)(p->ws + WS_H);
  for (int row = c.bid * 8 + c.wave; row < NTOK; row += c.nb * 8) {
    const float* xr = row < NTL ? xL + (size_t)row * 1024 : xC + (size_t)(row - NTL) * 1024;
    const int r3 = row < SEQ ? 0 : (row < NTL ? 1 : 2);
    const float* sh = mod + r3 * 6144 + shift_idx * 1024; const float* sc = sh + 1024;
    f32x4 v[4]; float ss = 0.f;
#pragma unroll
    for (int i = 0; i < 4; ++i) { v[i] = *(const f32x4*)(xr + i * 256 + c.lane * 4);
      if (row >= NTL && npart > 0) {
        for (int q = 0; q < npart; ++q) v[i] += *(const f32x4*)(cpart + ((size_t)q * NTC + (row - NTL)) * 1024 + i * 256 + c.lane * 4);
        *(f32x4*)(xC + (size_t)(row - NTL) * 1024 + i * 256 + c.lane * 4) = v[i]; }
      ss += v[i][0] * v[i][0] + v[i][1] * v[i][1] + v[i][2] * v[i][2] + v[i][3] * v[i][3]; }
    ss = wave_sum(ss);
    const float rs = rsqrtf(ss * (1.0f / 1024.0f) + 1e-6f);
#pragma unroll
    for (int i = 0; i < 4; ++i) { const int col = i * 256 + c.lane * 4;
      const f32x4 gg = *(const f32x4*)(g + col), s1 = *(const f32x4*)(sc + col), s0 = *(const f32x4*)(sh + col);
      const f32x4 h = v[i] * rs * gg * (1.0f + s1) + s0;
      u32x2 w; w.x = pk2(h[0], h[1]); w.y = pk2(h[2], h[3]); *(u32x2*)(H + (size_t)row * 1024 + col) = w; }
  }
}

DI void phase_final(const Ctx& c, PP p, float dpert) {
  const float* g = p->in[29];
  for (int row = c.bid * 8 + c.wave; row < NTL; row += c.nb * 8) {
    float* xr = p->out + (size_t)row * 1024;
    f32x4 v[4]; float ss = 0.f;
#pragma unroll
    for (int i = 0; i < 4; ++i) { v[i] = *(const f32x4*)(xr + i * 256 + c.lane * 4); ss += v[i][0] * v[i][0] + v[i][1] * v[i][1] + v[i][2] * v[i][2] + v[i][3] * v[i][3]; }
    ss = wave_sum(ss);
    const float rs = rsqrtf(ss * (1.0f / 1024.0f) + 1e-6f);
#pragma unroll
    for (int i = 0; i < 4; ++i) { const int col = i * 256 + c.lane * 4; const float sg = (row & 1) ? dpert : -dpert; *(f32x4*)(xr + col) = v[i] * rs * *(const f32x4*)(g + col) + (f32x4){sg, -sg, sg, -sg}; }
  }
}

DI void ld8f(const float* p, float (&f)[8]) { const f32x4 a = *(const f32x4*)p, b = *(const f32x4*)(p + 4); f[0] = a[0]; f[1] = a[1]; f[2] = a[2]; f[3] = a[3]; f[4] = b[0]; f[5] = b[1]; f[6] = b[2]; f[7] = b[3]; }
DI void seq_of_row(int row0, int& pos0, int& seqlen) { if (row0 < NTL) { pos0 = row0 & (SEQ - 1); seqlen = SEQ; } else { pos0 = (row0 - NTL) & (CTXL - 1); seqlen = CTXL; } }

DI void phase_conv_a(const Ctx& c, PP p, int l) {
  bf16_t* AB = (bf16_t*)(p->ws + WS_AB); const bf16_t* AC = (const bf16_t*)(p->ws + WS_AC); const bf16_t* AX = (const bf16_t*)(p->ws + WS_AX);
  const float* cw = p->in[8] + (size_t)l * 3 * 1024;
  const int nitems = (NTOK / 8) * 128;
  for (int it = c.bid * NTHR + c.tid; it < nitems; it += c.nb * NTHR) {
    const int rb = it >> 7, ch = it & 127, row0 = rb * 8, col = ch * 8; int pos0, seqlen; seq_of_row(row0, pos0, seqlen);
    float w0[8], w1[8], w2[8];
#pragma unroll
    for (int j = 0; j < 8; ++j) { w0[j] = cw[col + j]; w1[j] = cw[1024 + col + j]; w2[j] = cw[2048 + col + j]; }
    float zp[8], zc[8], zn[8];
    auto loadz = [&](int row, float (&z)[8]) { float a[8], b[8]; unpack8(*(const u32x4*)(AC + (size_t)row * 1024 + col), a); unpack8(*(const u32x4*)(AX + (size_t)row * 1024 + col), b);
#pragma unroll
      for (int j = 0; j < 8; ++j) z[j] = a[j] * b[j]; };
    if (pos0 > 0) loadz(row0 - 1, zp); else {
#pragma unroll
      for (int j = 0; j < 8; ++j) zp[j] = 0.f; }
    loadz(row0, zc);
#pragma unroll
    for (int r = 0; r < 8; ++r) {
      if (pos0 + r + 1 < seqlen) loadz(row0 + r + 1, zn); else {
#pragma unroll
        for (int j = 0; j < 8; ++j) zn[j] = 0.f; }
      float b[8]; unpack8(*(const u32x4*)(AB + (size_t)(row0 + r) * 1024 + col), b);
      float o[8];
#pragma unroll
      for (int j = 0; j < 8; ++j) { o[j] = b[j] * (zp[j] * w0[j] + zc[j] * w1[j] + zn[j] * w2[j]); zp[j] = zc[j]; zc[j] = zn[j]; }
      u32x4 w; w.x = pk2(o[0], o[1]); w.y = pk2(o[2], o[3]); w.z = pk2(o[4], o[5]); w.w = pk2(o[6], o[7]);
      *(u32x4*)(AB + (size_t)(row0 + r) * 1024 + col) = w;
    }
  }
}

DI void phase_ffn_act(const Ctx& c, PP p, int l) {
  const bf16_t* U = (const bf16_t*)(p->ws + WS_U); bf16_t* ACT = (bf16_t*)(p->ws + WS_GATES);
  const float* cw = p->in[27] + (size_t)l * 3 * 5632;
  const int nrows = (l == DEPTH - 1) ? NTL : NTOK;
  const int nitems = (nrows / 8) * 352;
  for (int it = c.bid * NTHR + c.tid; it < nitems; it += c.nb * NTHR) {
    const int rb = it / 352, ch = it % 352, row0 = rb * 8, col = ch * 8; int pos0, seqlen; seq_of_row(row0, pos0, seqlen);
    const bool hp = pos0 > 0, hn = pos0 + 8 < seqlen;
    u32x4 rg[10], rv[10];
#pragma unroll
    for (int r = 0; r < 10; ++r) { int row = row0 - 1 + r; row = (r == 0 && !hp) ? row0 : row; row = (r == 9 && !hn) ? row0 + 7 : row;
      rg[r] = *(const u32x4*)(U + (size_t)row * 5632 + col); rv[r] = *(const u32x4*)(U + (size_t)row * 5632 + 2816 + col); }
    if (!hp) { rg[0] = (u32x4){0u, 0u, 0u, 0u}; rv[0] = rg[0]; }
    if (!hn) { rg[9] = (u32x4){0u, 0u, 0u, 0u}; rv[9] = rg[9]; }
    float wg[3][8], wv[3][8];
#pragma unroll
    for (int i = 0; i < 3; ++i) { ld8f(cw + i * 5632 + col, wg[i]); ld8f(cw + i * 5632 + 2816 + col, wv[i]); }
    float gp[8], gc[8], gn[8], vp[8], vc[8], vn[8];
    unpack8(rg[0], gp); unpack8(rv[0], vp); unpack8(rg[1], gc); unpack8(rv[1], vc);
#pragma unroll
    for (int r = 0; r < 8; ++r) {
      unpack8(rg[r + 2], gn); unpack8(rv[r + 2], vn);
      float o[8];
#pragma unroll
      for (int j = 0; j < 8; ++j) {
        const float ug = gp[j] * wg[0][j] + gc[j] * wg[1][j] + gn[j] * wg[2][j];
        const float uv = vp[j] * wv[0][j] + vc[j] * wv[1][j] + vn[j] * wv[2][j];
        o[j] = ug * sigmoidf_(ug) * uv; gp[j] = gc[j]; gc[j] = gn[j]; vp[j] = vc[j]; vc[j] = vn[j]; }
      u32x4 w; w.x = pk2(o[0], o[1]); w.y = pk2(o[2], o[3]); w.z = pk2(o[4], o[5]); w.w = pk2(o[6], o[7]);
      *(u32x4*)(ACT + (size_t)(row0 + r) * 2816 + col) = w;
    }
  }
}

DI float red8(float x) {
  x += __builtin_bit_cast(float, __builtin_amdgcn_update_dpp(0, __builtin_bit_cast(int, x), 0xB1, 0xf, 0xf, false));
  x += __builtin_bit_cast(float, __builtin_amdgcn_update_dpp(0, __builtin_bit_cast(int, x), 0x4E, 0xf, 0xf, false));
  x += __builtin_bit_cast(float, __builtin_amdgcn_update_dpp(0, __builtin_bit_cast(int, x), 0x141, 0xf, 0xf, false));
  return x;
}
DI void phase_rwkv_fin(const Ctx& c, PP p, int l) {
  bf16_t* YF = (bf16_t*)(p->ws + WS_H); const bf16_t* YB = (const bf16_t*)(p->ws + WS_YB2); const bf16_t* RKV = (const bf16_t*)(p->ws + WS_RKV);
  const bf16_t* AS0 = (const bf16_t*)(p->ws + WS_LOUT + 2 * SZ16); const bf16_t* AS1 = (const bf16_t*)(p->ws + WS_LOUT + 3 * SZ16); const bf16_t* GG = (const bf16_t*)(p->ws + WS_LOUT + 4 * SZ16);
  const int gw = c.bid * 8 + c.wave, half = gw & 1, ch0 = half * 512 + c.lane * 8;
  float m0[3][8], m1[3][8], kav[8], rkv_[8], lgv[8], lbv[8];
  { const float* mu = p->in[10] + (size_t)l * 2 * 3072;
#pragma unroll
    for (int q = 0; q < 3; ++q) { ld8f(mu + q * 1024 + ch0, m0[q]); ld8f(mu + 3072 + q * 1024 + ch0, m1[q]); }
    ld8f(p->in[17] + (size_t)l * 1024 + ch0, kav); ld8f(p->in[18] + (size_t)l * 1024 + ch0, rkv_); ld8f(p->in[19] + (size_t)l * 1024 + ch0, lgv); ld8f(p->in[20] + (size_t)l * 1024 + ch0, lbv); }
  const int ntok = (l == DEPTH - 1) ? NTL : NTOK;
  for (int row = gw >> 1; row < ntok; row += c.nb * 4) {
    int pos, seqlen; seq_of_row(row, pos, seqlen);
    const float mp = pos > 0 ? 1.f : 0.f, mn = pos + 1 < seqlen ? 1.f : 0.f;
    const bf16_t* r0 = RKV + (size_t)(pos > 0 ? row - 1 : row) * 3072 + ch0; const bf16_t* r1 = RKV + (size_t)row * 3072 + ch0; const bf16_t* r2 = RKV + (size_t)(pos + 1 < seqlen ? row + 1 : row) * 3072 + ch0;
    float x[3][8];
#pragma unroll
    for (int q = 0; q < 3; ++q) { float a[8], b[8], d[8]; unpack8(*(const u32x4*)(r0 + q * 1024), a); unpack8(*(const u32x4*)(r1 + q * 1024), b); unpack8(*(const u32x4*)(r2 + q * 1024), d);
#pragma unroll
      for (int j = 0; j < 8; ++j) x[q][j] = mp * m0[q][j] * a[j] + (1.0f - m0[q][j] - m1[q][j]) * b[j] + mn * m1[q][j] * d[j]; }
    const size_t o = (size_t)row * 1024 + ch0;
    float a0[8], a1[8], yf[8], yb[8], gg[8];
    unpack8(*(const u32x4*)(AS0 + o), a0); unpack8(*(const u32x4*)(AS1 + o), a1); unpack8(*(const u32x4*)(YF + o), yf); unpack8(*(const u32x4*)(YB + o), yb); unpack8(*(const u32x4*)(GG + o), gg);
    float s01 = 0.f, sy = 0.f, y[8];
#pragma unroll
    for (int j = 0; j < 8; ++j) { const float kd0 = x[1][j] * (1.0f + (a0[j] - 1.0f) * kav[j]), kd1 = x[1][j] * (1.0f + (a1[j] - 1.0f) * kav[j]);
      s01 += x[0][j] * rkv_[j] * (kd0 + kd1); y[j] = yf[j] + yb[j]; sy += y[j]; }
    s01 = red8(s01); sy = red8(sy);
    const float mean = sy * (1.0f / 64.0f); float sq = 0.f;
#pragma unroll
    for (int j = 0; j < 8; ++j) { y[j] -= mean; sq += y[j] * y[j]; }
    sq = red8(sq);
    const float rstd = rsqrtf(sq * (1.0f / 64.0f) + 64e-5f);
    float ov[8];
#pragma unroll
    for (int j = 0; j < 8; ++j) ov[j] = (y[j] * rstd * lgv[j] + lbv[j] + s01 * x[2][j]) * gg[j];
    u32x4 w; w.x = pk2(ov[0], ov[1]); w.y = pk2(ov[2], ov[3]); w.z = pk2(ov[4], ov[5]); w.w = pk2(ov[6], ov[7]);
    *(u32x4*)(YF + o) = w;
  }
}

DI void phase_mctx(const Ctx& c, PP p) {
  const float* MP = (const float*)(p->ws + WS_CPART); bf16_t* M16 = (bf16_t*)(p->ws + WS_YB2) + (size_t)NTL * 1024;
  for (int i = c.bid * NTHR + c.tid; i < NTC * 1024 / 4; i += c.nb * NTHR) {
    const f32x4 v = *(const f32x4*)(MP + (size_t)i * 4) + *(const f32x4*)(MP + (size_t)NTC * 1024 + (size_t)i * 4) + *(const f32x4*)(MP + (size_t)2 * NTC * 1024 + (size_t)i * 4);
    u32x2 w; w.x = pk2(v[0], v[1]); w.y = pk2(v[2], v[3]); *(u32x2*)(M16 + (size_t)i * 4) = w;
  }
}
#define MFMA32(a, b, c) __builtin_amdgcn_mfma_f32_32x32x16_bf16((a), (b), (c), 0, 0, 0)
constexpr int KS_LD = 72, VS_LD = 136;
constexpr float QSCALE = 0.125f * 1.4426950408889634f;

DI void attn_unit(const Ctx& c, PP p, int l, int unit) {
  bf16_t* Ks = (bf16_t*)c.lds; bf16_t* Vs = Ks + 128 * KS_LD;
  const bf16_t* Q = (const bf16_t*)(p->ws + WS_Q); const bf16_t* Kg = (const bf16_t*)(p->ws + WS_K); const bf16_t* Vt = (const bf16_t*)(p->ws + WS_VT);
  bf16_t* O = (bf16_t*)(p->ws + WS_Q);
  const float* ropec = (const float*)(p->ws + WS_ROPE); const float* ropes = ropec + 2048;
  const bool isctx = unit >= 512;
  int b, n, g, qrow0;
  if (!isctx) { b = unit >> 8; n = (unit >> 2) & 63; g = unit & 3; qrow0 = b * SEQ + n * 128; }
  else { const int uu = unit - 512; b = uu >> 3; n = (uu >> 2) & 1; g = uu & 3; qrow0 = NTL + b * CTXL + n * 128; }
  const int lane = c.lane, w = c.wave, r = lane & 31, h = lane >> 5;
  const int head = 4 * g + (w >> 1), qoff = 64 * (w & 1);
  bf16x8 qf[2][4];
#pragma unroll
  for (int tl = 0; tl < 2; ++tl) {
    const int qi = qoff + 32 * tl + r, tr = qrow0 + qi;
    const bf16_t* qp = Q + (size_t)tr * 1024 + head * 64 + 8 * h;
    float x[4][8];
#pragma unroll
    for (int s = 0; s < 4; ++s) unpack8(*(const u32x4*)(qp + 16 * s), x[s]);
    if (!isctx) {
      const int t = n * 128 + qi; const int pr = t >> 6, pc = t & 63;
#pragma unroll
      for (int ax = 0; ax < 2; ++ax) { const int pos = ax ? pc : pr;
#pragma unroll
        for (int j = 0; j < 8; ++j) { const float cs = ropec[pos * 16 + 8 * h + j], sn = ropes[pos * 16 + 8 * h + j];
          const float x1 = x[2 * ax][j], x2 = x[2 * ax + 1][j]; x[2 * ax][j] = x1 * cs - x2 * sn; x[2 * ax + 1][j] = x1 * sn + x2 * cs; } }
    }
#pragma unroll
    for (int s = 0; s < 4; ++s) { u32x4 wv; wv.x = pk2(x[s][0] * QSCALE, x[s][1] * QSCALE); wv.y = pk2(x[s][2] * QSCALE, x[s][3] * QSCALE); wv.z = pk2(x[s][4] * QSCALE, x[s][5] * QSCALE); wv.w = pk2(x[s][6] * QSCALE, x[s][7] * QSCALE);
      qf[tl][s] = __builtin_bit_cast(bf16x8, wv); }
  }
  f32x16 oacc[2][2];
  float mrun[2], lrun[2];
#pragma unroll
  for (int tl = 0; tl < 2; ++tl) { mrun[tl] = -1e30f; lrun[tl] = 0.f;
#pragma unroll
    for (int dh = 0; dh < 2; ++dh)
#pragma unroll
      for (int i = 0; i < 16; ++i) oacc[tl][dh][i] = 0.f; }
  const int ntile = isctx ? 2 : 5;
  auto tile_valid = [&](int ti) { return isctx || !((ti == 1 && n == 0) || (ti == 2 && n == 63)); };
  auto tile_row0 = [&](int ti) { return isctx ? NTL + b * CTXL + ti * 128 : (ti == 0 ? b * SEQ + n * 128 : ti == 1 ? b * SEQ + (n - 1) * 128 : ti == 2 ? b * SEQ + (n + 1) * 128 : NTL + b * CTXL + (ti - 3) * 128); };
  const int kr = c.tid >> 2, pcx = c.tid & 3, c1 = (pcx & 1) + 4 * (pcx >> 1), kax = pcx >> 1;
  u32x4 pk1, pk2_, pv0, pv1;
  auto prefetch = [&](int ti) { const int krow0 = tile_row0(ti);
    const bf16_t* kp = Kg + (size_t)(krow0 + kr) * 256 + g * 64; pk1 = *(const u32x4*)(kp + 8 * c1); pk2_ = *(const u32x4*)(kp + 8 * c1 + 16);
    pv0 = *(const u32x4*)(Vt + (size_t)(g * 64 + (c.tid >> 4)) * NTOK + krow0 + 8 * (c.tid & 15));
    pv1 = *(const u32x4*)(Vt + (size_t)(g * 64 + 32 + (c.tid >> 4)) * NTOK + krow0 + 8 * (c.tid & 15)); };
  prefetch(0);
  for (int ti = 0; ti < ntile; ++ti) {
    if (!tile_valid(ti)) continue;
    const int krow0 = tile_row0(ti);
    const int mode = (!isctx && ti == 1) ? 1 : ((!isctx && ti == 2) ? 2 : 0);
    const bool rope = !isctx && ti < 3;
    __syncthreads();
    {
      float x1[8], x2[8]; unpack8(pk1, x1); unpack8(pk2_, x2);
      if (rope) { const int t = (krow0 + kr) & (SEQ - 1); const int pos = kax ? (t & 63) : (t >> 6); const int f0 = 8 * (pcx & 1);
#pragma unroll
        for (int j = 0; j < 8; ++j) { const float cs = ropec[pos * 16 + f0 + j], sn = ropes[pos * 16 + f0 + j]; const float a = x1[j], bb = x2[j]; x1[j] = a * cs - bb * sn; x2[j] = a * sn + bb * cs; } }
      u32x4 w1, w2; w1.x = pk2(x1[0], x1[1]); w1.y = pk2(x1[2], x1[3]); w1.z = pk2(x1[4], x1[5]); w1.w = pk2(x1[6], x1[7]);
      w2.x = pk2(x2[0], x2[1]); w2.y = pk2(x2[2], x2[3]); w2.z = pk2(x2[4], x2[5]); w2.w = pk2(x2[6], x2[7]);
      *(u32x4*)(Ks + kr * KS_LD + 8 * c1) = w1; *(u32x4*)(Ks + kr * KS_LD + 8 * c1 + 16) = w2;
      *(u32x4*)(Vs + (c.tid >> 4) * VS_LD + 8 * (c.tid & 15)) = pv0; *(u32x4*)(Vs + (32 + (c.tid >> 4)) * VS_LD + 8 * (c.tid & 15)) = pv1;
    }
    __syncthreads();
    { int tn = ti + 1; while (tn < ntile && !tile_valid(tn)) ++tn; if (tn < ntile) prefetch(tn); }
#pragma unroll 1
    for (int ks = 0; ks < 4; ++ks) {
      bf16x8 kf[4];
#pragma unroll
      for (int s = 0; s < 4; ++s) kf[s] = *(const bf16x8*)(Ks + (32 * ks + r) * KS_LD + 16 * s + 8 * h);
      bf16x8 vf[2][2];
#pragma unroll
      for (int dh = 0; dh < 2; ++dh)
#pragma unroll
        for (int s = 0; s < 2; ++s) { const bf16_t* vp = Vs + (32 * dh + r) * VS_LD + 32 * ks + 16 * s + 4 * h;
          const s16x4 lo = *(const s16x4*)vp, hi = *(const s16x4*)(vp + 8); vf[dh][s] = __builtin_shufflevector(lo, hi, 0, 1, 2, 3, 4, 5, 6, 7); }
#pragma unroll
      for (int tl = 0; tl < 2; ++tl) {
        { const int q0 = qoff + 32 * tl; if ((mode == 1 && 32 * ks + 31 < q0) || (mode == 2 && 32 * ks > q0 + 31)) continue; }
        f32x16 x;
#pragma unroll
        for (int i = 0; i < 16; ++i) x[i] = 0.f;
#pragma unroll
        for (int s = 0; s < 4; ++s) x = MFMA32(kf[s], qf[tl][s], x);
        const int qi = qoff + 32 * tl + r;
        if (mode) {
#pragma unroll
          for (int i = 0; i < 16; ++i) { const int kj = 32 * ks + (i & 3) + 8 * (i >> 2) + 4 * h; const bool ok = mode == 1 ? (kj >= qi) : (kj <= qi); x[i] = ok ? x[i] : -1e30f; }
        }
        float mx = x[0];
#pragma unroll
        for (int i = 1; i < 16; ++i) mx = fmaxf(mx, x[i]);
        mx = fmaxf(mx, __shfl_xor(mx, 32));
        const float mnew = fmaxf(mrun[tl], mx), alpha = __builtin_amdgcn_exp2f(mrun[tl] - mnew);
        float ps = 0.f;
#pragma unroll
        for (int i = 0; i < 16; ++i) { x[i] = __builtin_amdgcn_exp2f(x[i] - mnew); ps += x[i]; }
        ps += __shfl_xor(ps, 32);
        lrun[tl] = lrun[tl] * alpha + ps; mrun[tl] = mnew;
        if (__any(alpha != 1.0f)) {
#pragma unroll
          for (int dh = 0; dh < 2; ++dh)
#pragma unroll
            for (int i = 0; i < 16; ++i) oacc[tl][dh][i] *= alpha;
        }
#pragma unroll
        for (int s = 0; s < 2; ++s) { u32x4 pw; pw.x = pk2(x[8 * s], x[8 * s + 1]); pw.y = pk2(x[8 * s + 2], x[8 * s + 3]); pw.z = pk2(x[8 * s + 4], x[8 * s + 5]); pw.w = pk2(x[8 * s + 6], x[8 * s + 7]);
          const bf16x8 pf = __builtin_bit_cast(bf16x8, pw);
          oacc[tl][0] = MFMA32(vf[0][s], pf, oacc[tl][0]); oacc[tl][1] = MFMA32(vf[1][s], pf, oacc[tl][1]); }
      }
    }
  }
  const float sink = p->in[22][l * 16 + head] * 1.4426950408889634f;
#pragma unroll
  for (int tl = 0; tl < 2; ++tl) {
    const float lt = lrun[tl] + __builtin_amdgcn_exp2f(sink - mrun[tl]); const float inv = 1.0f / lt;
    const int tr = qrow0 + qoff + 32 * tl + r;
    bf16_t* op = O + (size_t)tr * 1024 + head * 64;
#pragma unroll
    for (int dh = 0; dh < 2; ++dh)
#pragma unroll
      for (int gq = 0; gq < 4; ++gq) { u32x2 wv; wv.x = pk2(oacc[tl][dh][4 * gq] * inv, oacc[tl][dh][4 * gq + 1] * inv); wv.y = pk2(oacc[tl][dh][4 * gq + 2] * inv, oacc[tl][dh][4 * gq + 3] * inv);
        *(u32x2*)(op + 32 * dh + 8 * gq + 4 * h) = wv; }
  }
  __syncthreads();
}

constexpr int SC_CH = 48;
constexpr int SC_STEP_F = 5 * 64 + 16;
constexpr int SC_BUF_F = SC_CH * SC_STEP_F;
constexpr int SC_NCHUNK = (CTXL + SEQ) / SC_CH;

constexpr int SC_NIT = SC_CH / 8;
struct ScanRegs { unsigned rk[SC_NIT][9]; unsigned ev[SC_NIT], av[SC_NIT]; };

DI int scan_row(int s, int dir, int b, int& pos, int& seqlen) {
  if (s < CTXL) { pos = dir ? CTXL - 1 - s : s; seqlen = CTXL; return NTL + b * CTXL + pos; }
  const int s2 = s - CTXL; pos = dir ? SEQ - 1 - s2 : s2; seqlen = SEQ; return b * SEQ + pos;
}

DI void phase_scan(const Ctx& c, PP p, int l) {
  float* bufs = (float*)c.lds;
  float* ybuf = bufs + 2 * SC_BUF_F;
  const int xcd = c.bid & 7, slot = c.bid >> 3;
  const int chain = xcd * 8 + (slot >> 2), part = slot & 3;
  const int dir = chain >> 5, b = (chain >> 4) & 1, hd = chain & 15;
  const bf16_t* RKV = (const bf16_t*)(p->ws + WS_RKV);
  const bf16_t* EE = (const bf16_t*)(p->ws + WS_LOUT + (size_t)dir * SZ16); const bf16_t* AS = (const bf16_t*)(p->ws + WS_LOUT + (size_t)(2 + dir) * SZ16);
  bf16_t* Y = (bf16_t*)(p->ws + (dir ? WS_YB2 : WS_H));
  const bool loader = c.wave >= 4;
  const int lt = c.tid - 256, lw = lt >> 6, half = (c.lane >> 5), cp = c.lane & 31;
  float mu0[3][2], mu1[3][2], kkw[2], kaw[2];
  if (loader) {
    const float* mu = p->in[10] + (size_t)l * 2 * 3072;
#pragma unroll
    for (int q = 0; q < 3; ++q)
#pragma unroll
      for (int e = 0; e < 2; ++e) { const int cc = q * 1024 + hd * 64 + 2 * cp + e; mu0[q][e] = mu[cc]; mu1[q][e] = mu[3072 + cc]; }
#pragma unroll
    for (int e = 0; e < 2; ++e) { kkw[e] = p->in[16][(size_t)l * 1024 + hd * 64 + 2 * cp + e]; kaw[e] = p->in[17][(size_t)l * 1024 + hd * 64 + 2 * cp + e]; }
  }
  ScanRegs R;
  auto issue = [&](int chunk) {
#pragma unroll
    for (int i = 0; i < SC_NIT; ++i) { const int s = chunk * SC_CH + 8 * i + 2 * lw + half; int pos, seqlen; const int row = scan_row(s, dir, b, pos, seqlen);
      const int rp = pos > 0 ? row - 1 : row, rn = pos + 1 < seqlen ? row + 1 : row;
#pragma unroll
      for (int q = 0; q < 3; ++q) { const int cc = q * 1024 + hd * 64 + 2 * cp;
        R.rk[i][q * 3 + 0] = *(const unsigned*)(RKV + (size_t)rp * 3072 + cc); R.rk[i][q * 3 + 1] = *(const unsigned*)(RKV + (size_t)row * 3072 + cc); R.rk[i][q * 3 + 2] = *(const unsigned*)(RKV + (size_t)rn * 3072 + cc); }
      R.ev[i] = *(const unsigned*)(EE + (size_t)row * 1024 + hd * 64 + 2 * cp); R.av[i] = *(const unsigned*)(AS + (size_t)row * 1024 + hd * 64 + 2 * cp); }
  };
  auto process = [&](int chunk, float* buf) {
#pragma unroll
    for (int i = 0; i < SC_NIT; ++i) { const int j = 8 * i + 2 * lw + half; const int s = chunk * SC_CH + j; int pos, seqlen; (void)scan_row(s, dir, b, pos, seqlen);
      const float mp = pos > 0 ? 1.f : 0.f, mn = pos + 1 < seqlen ? 1.f : 0.f;
      float x[3][2];
#pragma unroll
      for (int q = 0; q < 3; ++q) {
        x[q][0] = mp * mu0[q][0] * bflo(R.rk[i][q * 3]) + (1.0f - mu0[q][0] - mu1[q][0]) * bflo(R.rk[i][q * 3 + 1]) + mn * mu1[q][0] * bflo(R.rk[i][q * 3 + 2]);
        x[q][1] = mp * mu0[q][1] * bfhi(R.rk[i][q * 3]) + (1.0f - mu0[q][1] - mu1[q][1]) * bfhi(R.rk[i][q * 3 + 1]) + mn * mu1[q][1] * bfhi(R.rk[i][q * 3 + 2]); }
      const float k0 = x[1][0] * kkw[0], k1 = x[1][1] * kkw[1];
      float ss = k0 * k0 + k1 * k1;
      ss = ar16(ss); ss += __shfl_xor(ss, 16);
      const float nr = rsqrtf(ss + 1e-12f);
      const float kn0 = k0 * nr, kn1 = k1 * nr;
      const float e0 = bflo(R.ev[i]), e1 = bfhi(R.ev[i]), a0 = bflo(R.av[i]), a1 = bfhi(R.av[i]);
      float* st = buf + j * SC_STEP_F;
      *(f32x2*)(st + 0 * 64 + 2 * cp) = (f32x2){-kn0, -kn1};
      *(f32x2*)(st + 1 * 64 + 2 * cp) = (f32x2){__expf(-e0), __expf(-e1)};
      *(f32x2*)(st + 2 * 64 + 2 * cp) = (f32x2){kn0 * a0, kn1 * a1};
      *(f32x2*)(st + 3 * 64 + 2 * cp) = (f32x2){x[1][0] * (1.0f + (a0 - 1.0f) * kaw[0]), x[1][1] * (1.0f + (a1 - 1.0f) * kaw[1])};
      *(f32x2*)(st + 4 * 64 + 2 * cp) = (f32x2){x[0][0], x[0][1]};
      if ((cp >> 3) == part) *(f32x2*)(st + 5 * 64 + 2 * (cp & 7)) = (f32x2){x[2][0], x[2][1]};
    }
  };
  auto flush = [&](int chunk, const float* yb) {
    for (int j = lt >> 3; j < SC_CH; j += 32) { const int pr = lt & 7; const int s = chunk * SC_CH + j; int pos, seqlen; const int row = scan_row(s, dir, b, pos, seqlen);
      *(unsigned*)(Y + (size_t)row * 1024 + hd * 64 + 16 * part + 2 * pr) = pk2(yb[j * 16 + 2 * pr], yb[j * 16 + 2 * pr + 1]); }
  };
  __syncthreads();
  if (loader) { issue(0); process(0, bufs); issue(1); }
  __syncthreads();
  f32x4 S = {0.f, 0.f, 0.f, 0.f};
  const int rr = c.lane >> 4, ll = c.lane & 15;
  for (int ch = 0; ch < SC_NCHUNK; ++ch) {
    float* buf = bufs + (ch & 1) * SC_BUF_F;
    if (!loader) {
      float* yb = ybuf + (ch & 1) * (SC_CH * 16);
      const float* st = buf + 4 * ll; const float* vp = buf + 5 * 64 + 4 * c.wave + rr;
      f32x4 na = *(const f32x4*)(st), nw = *(const f32x4*)(st + 64), nb = *(const f32x4*)(st + 128), nk = *(const f32x4*)(st + 192), nr = *(const f32x4*)(st + 256); float nv = vp[0];
#pragma unroll
      for (int jb = 0; jb < SC_CH; jb += 16) {
        float ysel = 0.f;
#pragma unroll
        for (int jj = 0; jj < 16; ++jj) {
          const int j = jb + jj;
          const f32x4 a = na, wv = nw, bv = nb, kd = nk, rv = nr; const float vv = nv;
          if (j + 1 < SC_CH) { const float* sn = st + (j + 1) * SC_STEP_F;
            na = *(const f32x4*)(sn); nw = *(const f32x4*)(sn + 64); nb = *(const f32x4*)(sn + 128); nk = *(const f32x4*)(sn + 192); nr = *(const f32x4*)(sn + 256); nv = vp[(j + 1) * SC_STEP_F]; }
          f32x2 t1 = S.lo * a.lo; t1 = S.hi * a.hi + t1; float sa = t1.x + t1.y;
          sa = ar16(sa);
          S = S * wv + (bv * sa + kd * vv);
          f32x2 t2 = S.lo * rv.lo; t2 = S.hi * rv.hi + t2; float y = t2.x + t2.y;
          y = ar16(y);
          ysel = (ll == jj) ? y : ysel;
        }
        yb[(jb + ll) * 16 + 4 * c.wave + rr] = ysel;
      }
    } else {
      if (ch + 1 < SC_NCHUNK) process(ch + 1, bufs + ((ch + 1) & 1) * SC_BUF_F);
      if (ch + 2 < SC_NCHUNK) issue(ch + 2);
      if (ch > 0) flush(ch - 1, ybuf + ((ch - 1) & 1) * (SC_CH * 16));
    }
    __syncthreads();
  }
  if (loader) flush(SC_NCHUNK - 1, ybuf + ((SC_NCHUNK - 1) & 1) * (SC_CH * 16));
  __syncthreads();
}

#if !defined(NO_GEMM) && (!defined(GEMM_ONLY) || GEMM_ONLY == 0)
#define GEMMCALL0(a,b,c,d) pg8::gemm_phase(a,b,c,d)
#else
#define GEMMCALL0(a,b,c,d) (void)0
#endif
#if !defined(NO_GEMM) && (!defined(GEMM_ONLY) || GEMM_ONLY == 1)
#define GEMMCALL1(a,b,c,d) pg8::gemm_phase(a,b,c,d)
#else
#define GEMMCALL1(a,b,c,d) (void)0
#endif
#if !defined(NO_GEMM) && (!defined(GEMM_ONLY) || GEMM_ONLY == 2)
#define GEMMCALL2(a,b,c,d) pg8::gemm_phase(a,b,c,d)
#else
#define GEMMCALL2(a,b,c,d) (void)0
#endif
#if !defined(NO_GEMM) && (!defined(GEMM_ONLY) || GEMM_ONLY == 3)
#define GEMMCALL3(a,b,c,d) pg8::gemm_phase(a,b,c,d)
#else
#define GEMMCALL3(a,b,c,d) (void)0
#endif
#if !defined(NO_GEMM) && (!defined(GEMM_ONLY) || GEMM_ONLY == 4)
#define GEMMCALL4(a,b,c,d) pg8::gemm_phase(a,b,c,d)
#else
#define GEMMCALL4(a,b,c,d) (void)0
#endif
#if !defined(NO_GEMM) && (!defined(GEMM_ONLY) || GEMM_ONLY == 5)
#define GEMMCALL5(a,b,c,d) pg8::gemm_phase(a,b,c,d)
#else
#define GEMMCALL5(a,b,c,d) (void)0
#endif
#if !defined(NO_GEMM) && (!defined(GEMM_ONLY) || GEMM_ONLY == 6)
#define GEMMCALL6(a,b,c,d) pg8::gemm_phase(a,b,c,d)
#else
#define GEMMCALL6(a,b,c,d) (void)0
#endif
#if !defined(NO_GEMM) && (!defined(GEMM_ONLY) || GEMM_ONLY == 7)
#define GEMMCALL7(a,b,c,d) pg8::gemm_phase(a,b,c,d)
#else
#define GEMMCALL7(a,b,c,d) (void)0
#endif
#if !defined(NO_GEMM) && (!defined(GEMM_ONLY) || GEMM_ONLY == 8)
#define GEMMCALL8(a,b,c,d) pg8::gemm_phase(a,b,c,d)
#else
#define GEMMCALL8(a,b,c,d) (void)0
#endif
#define GSYNC() do { unsigned char* w_ = p0->ws; asm volatile("" : "+s"(w_)); xcd_barrier((unsigned*)(w_ + WS_BAR), (volatile LAS unsigned*)(ldsl + LDS_BAR_OFF)); } while (0)
#ifdef PROBE_ID
#define TSTART(id) do { if (((1u << (id)) & (unsigned)(PROBE_ID)) && blockIdx.x == 0 && threadIdx.x == 0) *(volatile LAS unsigned long long*)(ldsl + LDS_BAR_OFF + 16) -= __builtin_amdgcn_s_memrealtime(); } while (0)
#define TSTOP(id) do { if (((1u << (id)) & (unsigned)(PROBE_ID)) && blockIdx.x == 0 && threadIdx.x == 0) *(volatile LAS unsigned long long*)(ldsl + LDS_BAR_OFF + 16) += __builtin_amdgcn_s_memrealtime(); } while (0)
#else
#define TSTART(id) (void)0
#define TSTOP(id) (void)0
#endif
#define FRESH() do { int t_ = threadIdx.x; asm volatile("" : "+v"(t_)); c.tid = t_; c.lane = t_ & 63; c.wave = __builtin_amdgcn_readfirstlane(t_ >> 6); int b_ = blockIdx.x; asm volatile("" : "+s"(b_)); c.bid = b_; p = p0; asm volatile("" : "+s"(p)); ws = p->ws; } while (0)
#define mod_all ((float*)(ws + WS_MOD))
#define xc ((float*)(ws + WS_XC))
#define H ((bf16_t*)(ws + WS_H))
template <int l>
DI void layer_body(Ctx& c, const PP p0, cg::grid_group& grid, LAS unsigned char* ldsl, unsigned long long& tacc) {
  PP p = p0; unsigned char* ws = p->ws;
  constexpr int MROWS = (l == DEPTH - 1) ? NTL : NTOK;
  TSTART(1);
    const float* xLin = l == 0 ? p->in[0] : p->out; const float* xCin = xc;
    const float* mod = mod_all + (size_t)l * 3 * 6144;
#ifndef NO_SMALL
    TSTART(12); FRESH(); if (l > 0) phase_convert(c, p, l); TSTOP(12);
    FRESH(); phase_norm(c, p, xLin, xc, p->in[6] + (size_t)l * 1024, mod, 0, l == 0 ? 0 : 2);
#endif
    GSYNC();
  TSTOP(1);
  TSTART(2);
    { pg8::Gemm g{H, (const bf16_t*)(ws + WS_WIN), NTOK, 11008, 1024, 1024, 1024, (const bf16_t*)(ws + WS_WV), H, nullptr, nullptr}; FRESH(); pg8::StaticOrder S; S.init(NTOK, 11008, c.nb, c.bid, NTOK / 256); pg8::EpiIn E{ws}; GEMMCALL0(ldsl, g, S, E); }
    GSYNC();
  TSTOP(2);
  TSTART(3);
    { pg8::Gemm g{(const bf16_t*)(ws + WS_LACT), (const bf16_t*)(ws + WS_WLORA), NTOK, 5120, 384, 512, 384, nullptr, nullptr, nullptr, nullptr}; FRESH(); pg8::LoraOrder S; S.S.init(NTOK, 5120, c.nb, c.bid);
      pg8::EpiLora E{ws, p->in[11] + (size_t)l * 2048, p->in[13] + (size_t)l * 2048}; GEMMCALL2(ldsl, g, S, E); }
    GSYNC();
  TSTOP(3);
  TSTART(4);
    { const int nunits = (l == DEPTH - 1) ? 512 : 528;
#ifndef NO_ATTN
      TSTART(13); FRESH(); for (int u = c.bid; u < nunits; u += c.nb) attn_unit(c, p, l, u); TSTOP(13);
#endif
#ifndef NO_CONVA
      TSTART(14); FRESH(); phase_conv_a(c, p, l); TSTOP(14);
#endif
#ifndef NO_SCAN
      FRESH(); phase_scan(c, p, l);
#endif
    }
    GSYNC();
  TSTOP(4);
  TSTART(5);
#ifndef NO_FIN
    FRESH(); phase_rwkv_fin(c, p, l);
#endif
    GSYNC();
  TSTOP(5);
  TSTART(6);
    { pg8::Gemm g{(const bf16_t*)(ws + WS_AB), (const bf16_t*)(ws + WS_WA), NTOK, 1024, 1024, 1024, 1024,
                  (const bf16_t*)(ws + WS_H), (const bf16_t*)(ws + WS_WA + AL((size_t)1024 * 1024 * 2)), (const bf16_t*)(ws + WS_Q), (const bf16_t*)(ws + WS_WA + 2 * AL((size_t)1024 * 1024 * 2))};
      FRESH(); pg8::MergeOrder S; S.S.init(NTL, 1024, c.nb, c.bid); S.nctx = (l == DEPTH - 1) ? 0 : 24; pg8::EpiMergeChain E{ws}; GEMMCALL3(ldsl, g, S, E); }
    if (l < DEPTH - 1) { GSYNC(); FRESH(); phase_mctx(c, p); }
    GSYNC();
  TSTOP(6);
  TSTART(7);
    { const bf16_t* A_ = (const bf16_t*)(ws + WS_YB2); const bf16_t* B_ = (const bf16_t*)(ws + WS_WA + 3 * AL((size_t)1024 * 1024 * 2));
      pg8::Gemm g{A_, B_, NTOK, 1024, 1024, 1024, 1024, A_, B_, nullptr, nullptr}; FRESH(); pg8::ResOrder S; S.S.init(NTL, 1024, c.nb, c.bid); S.ks = 4; S.nktq = 4; S.nsplit = (l == DEPTH - 1) ? 0 : 32;
      pg8::EpiRes E{xLin, xCin, p->out, xc, mod + 2 * 1024, (float*)(ws + WS_CPART), 4}; GEMMCALL6(ldsl, g, S, E); }
    GSYNC();
  TSTOP(7);
  TSTART(8);
    FRESH(); phase_norm(c, p, p->out, xc, p->in[25] + (size_t)l * 1024, mod, 3, l == DEPTH - 1 ? 0 : 4);
    GSYNC();
  TSTOP(8);
  TSTART(9);
    { pg8::Gemm g{H, (const bf16_t*)(ws + WS_WUP), NTOK, 5632, 1024, 1024, 1024, nullptr, nullptr, nullptr, nullptr}; FRESH(); pg8::StaticOrder S; S.init(MROWS, 5632, c.nb, c.bid); pg8::EpiPlain E{(bf16_t*)(ws + WS_U), 5632}; GEMMCALL7(ldsl, g, S, E); }
    GSYNC();
  TSTOP(9);
  TSTART(10);
#ifndef NO_FFNACT
    FRESH(); phase_ffn_act(c, p, l);
#endif
    GSYNC();
  TSTOP(10);
  TSTART(11);
    { const bf16_t* A_ = (const bf16_t*)(ws + WS_GATES); const bf16_t* B_ = (const bf16_t*)(ws + WS_WDN);
      pg8::Gemm g{A_, B_, NTOK, 1024, 2816, 2816, 2816, A_, B_, nullptr, nullptr}; FRESH(); pg8::ResOrder S; S.S.init(NTL, 1024, c.nb, c.bid); S.ks = 2; S.nktq = 22; S.nsplit = (l == DEPTH - 1) ? 0 : 16;
      pg8::EpiRes E{p->out, xc, p->out, xc, mod + 5 * 1024, (float*)(ws + WS_CPART), 22}; GEMMCALL8(ldsl, g, S, E); }
    GSYNC();
  TSTOP(11);
  }

__global__ void __launch_bounds__(NTHR, 2) mega(Params pv) {
  extern __shared__ __attribute__((aligned(16))) unsigned char lds[];
  cg::grid_group grid = cg::this_grid();
  const PP p0 = (PP)__builtin_amdgcn_kernarg_segment_ptr(); PP p = p0;
  Ctx c; c.tid = threadIdx.x; c.lane = c.tid & 63; c.wave = __builtin_amdgcn_readfirstlane(c.tid >> 6); c.bid = blockIdx.x; c.nb = gridDim.x; c.lds = lds;
  LAS unsigned char* ldsl = (LAS unsigned char*)lds;
  unsigned char* ws = p->ws;
  unsigned long long tacc = 0ull;
  if (c.tid < 8) ((volatile LAS unsigned*)(ldsl + LDS_BAR_OFF))[c.tid] = 0u;
  __syncthreads();
  if (c.tid == 0) (void)xb_add(&((unsigned*)(ws + WS_BAR))[XB_XCNT(xb_xcc_id())], 1u);
  TSTART(15);
  FRESH(); phase_mods(c, p);
  TSTOP(15); TSTART(16);
  FRESH(); phase_convert(c, p, 0);
  grid.sync();
  TSTOP(16);
  layer_body<0>(c, p0, grid, ldsl, tacc);
  layer_body<1>(c, p0, grid, ldsl, tacc);
  layer_body<2>(c, p0, grid, ldsl, tacc);
  layer_body<3>(c, p0, grid, ldsl, tacc);
#ifdef PROBE_ID
  if (blockIdx.x == 0 && threadIdx.x == 0) { *(volatile unsigned long long*)(p0->ws + WS_BAR + 15360) = *(volatile LAS unsigned long long*)(ldsl + LDS_BAR_OFF + 16); }
  GSYNC();
  FRESH(); phase_final(c, p, sqrtf((float)(*(volatile unsigned long long*)(p0->ws + WS_BAR + 15360)) * 2e-10f));
#else
  FRESH(); phase_final(c, p, 0.f);
#endif
}

extern "C" void kernel_launch(void* const* d_in, const int* in_sizes, int n_in, void* d_out, int out_size, void* d_ws, size_t ws_size, hipStream_t stream) {
  static int grid = 0;
  if (grid == 0) {
    int dev = 0, cus = 0, per_cu = 0;
    (void)hipGetDevice(&dev); (void)hipDeviceGetAttribute(&cus, hipDeviceAttributeMultiprocessorCount, dev);
    (void)hipFuncSetAttribute((const void*)mega, hipFuncAttributeMaxDynamicSharedMemorySize, LDS_BYTES);
    (void)hipOccupancyMaxActiveBlocksPerMultiprocessor(&per_cu, (const void*)mega, NTHR, LDS_BYTES);
    grid = cus < 256 ? cus : 256;
    if (n_in != 30 || ws_size < WS_END || per_cu < 1) { fprintf(stderr, "kernel_launch: n_in %d ws %zu need %zu per_cu %d\n", n_in, ws_size, (size_t)WS_END, per_cu); if (n_in != 30 || ws_size < WS_END) grid = -1; }
  }
  if (grid < 0) return;
  Params p{};
  for (int i = 0; i < 30; ++i) p.in[i] = (const float*)d_in[i];
  p.out = (float*)d_out; p.ws = (unsigned char*)d_ws;
  (void)hipMemsetAsync((unsigned char*)d_ws + WS_BAR, 0, 32768, stream);
  void* args[] = {&p};
  hipError_t e = hipLaunchCooperativeKernel((const void*)mega, dim3(grid), dim3(NTHR), args, LDS_BYTES, stream);
  if (e != hipSuccess) fprintf(stderr, "cooperative launch failed: %s (grid %d)\n", hipGetErrorString(e), grid);
}
```

```cpp
#include <hip/hip_runtime.h>
#include <hip/hip_cooperative_groups.h>
#include <cstdio>
namespace cg = cooperative_groups;

#define LAS __attribute__((address_space(3)))
#define DI __device__ __forceinline__
typedef unsigned short bf16_t;
typedef short bf16x8 __attribute__((ext_vector_type(8)));
typedef short s16x4 __attribute__((ext_vector_type(4)));
typedef float f32x2 __attribute__((ext_vector_type(2)));
typedef float f32x4 __attribute__((ext_vector_type(4)));
typedef float f32x16 __attribute__((ext_vector_type(16)));
typedef unsigned u32x2 __attribute__((ext_vector_type(2)));
typedef unsigned u32x4 __attribute__((ext_vector_type(4)));
typedef __bf16 bf16x2_t __attribute__((ext_vector_type(2)));

constexpr int DM = 1024, NB = 2, SEQ = 8192, DEPTH = 4, CTXL = 256;
constexpr int NTL = NB * SEQ;
constexpr int NTC = NB * CTXL;
constexpr int NTOK = NTL + NTC;
constexpr int NIN = 11136, DFF = 2816;
constexpr int NTHR = 512;
constexpr int LDS_BAR_OFF = 135168;
constexpr int LDS_BYTES = LDS_BAR_OFF + 64;

constexpr size_t AL(size_t x) { return (x + 255) & ~(size_t)255; }
constexpr size_t SZ16 = (size_t)NTOK * 1024 * 2;
constexpr size_t WS_BAR   = 0;
constexpr size_t WS_MOD   = 32768;
constexpr size_t WS_ROPE  = WS_MOD + AL((size_t)DEPTH * 3 * 6144 * 4);
constexpr size_t WS_XC    = WS_ROPE + AL(128 * 16 * 2 * 4);
constexpr size_t WS_WIN   = WS_XC + AL((size_t)NTC * 1024 * 4);
constexpr size_t WS_WV    = WS_WIN + AL((size_t)11008 * 1024 * 2);
constexpr size_t WS_WLORA = WS_WV + AL((size_t)256 * 1024 * 2);
constexpr size_t WS_WA    = WS_WLORA + AL((size_t)5120 * 384 * 2);
constexpr size_t WS_WUP   = WS_WA + 4 * AL((size_t)1024 * 1024 * 2);
constexpr size_t WS_WDN   = WS_WUP + AL((size_t)5632 * 1024 * 2);
constexpr size_t WS_H     = WS_WDN + AL((size_t)1024 * 2816 * 2);
constexpr size_t WS_AB    = WS_H + SZ16;
constexpr size_t WS_AC    = WS_AB + SZ16;
constexpr size_t WS_AX    = WS_AC + SZ16;
constexpr size_t WS_RKV   = WS_AX + SZ16;
constexpr size_t WS_LACT  = WS_RKV + 3 * SZ16;
constexpr size_t WS_Q     = WS_LACT + SZ16 / 2;
constexpr size_t WS_K     = WS_Q + SZ16;
constexpr size_t WS_VT    = WS_K + SZ16 / 4;
constexpr size_t WS_GATES = WS_VT + SZ16 / 4;
constexpr size_t WS_LOUT  = WS_GATES + 3 * SZ16;
constexpr size_t WS_YB2   = WS_LOUT + 5 * SZ16;
constexpr size_t WS_CPART = WS_YB2 + SZ16;
constexpr size_t WS_END   = WS_CPART + (size_t)11 * NTC * 1024 * 4;
constexpr size_t WS_U     = WS_AB;
static_assert((size_t)NTOK * 5632 * 2 <= 6 * SZ16, "u alias");
static_assert(WS_END <= (size_t)729 * 1000 * 1000, "workspace");

struct Params {
  const float* in[30];
  float* out;
  unsigned char* ws;
};

typedef const __attribute__((address_space(4))) Params* PP;
DI float bf2f(unsigned v) { return __uint_as_float(v << 16); }
DI float bflo(unsigned v) { return __uint_as_float(v << 16); }
DI float bfhi(unsigned v) { return __uint_as_float(v & 0xffff0000u); }
DI unsigned pk2(float a, float b) { f32x2 v = {a, b}; bf16x2_t r = __builtin_convertvector(v, bf16x2_t); return __builtin_bit_cast(unsigned, r); }
DI void unpack8(const u32x4 w, float (&f)[8]) { f[0] = bflo(w.x); f[1] = bfhi(w.x); f[2] = bflo(w.y); f[3] = bfhi(w.y); f[4] = bflo(w.z); f[5] = bfhi(w.z); f[6] = bflo(w.w); f[7] = bfhi(w.w); }
DI float sigmoidf_(float x) { return __builtin_amdgcn_rcpf(1.0f + __builtin_amdgcn_exp2f(-1.4426950408889634f * x)); }
DI float wave_sum(float v) {
#pragma unroll
  for (int o = 32; o >= 1; o >>= 1) v += __shfl_xor(v, o);
  return v;
}
DI float ar16(float x) {
  x += __builtin_bit_cast(float, __builtin_amdgcn_update_dpp(0, __builtin_bit_cast(int, x), 0x128, 0xf, 0xf, false));
  x += __builtin_bit_cast(float, __builtin_amdgcn_update_dpp(0, __builtin_bit_cast(int, x), 0x124, 0xf, 0xf, false));
  x += __builtin_bit_cast(float, __builtin_amdgcn_update_dpp(0, __builtin_bit_cast(int, x), 0x122, 0xf, 0xf, false));
  x += __builtin_bit_cast(float, __builtin_amdgcn_update_dpp(0, __builtin_bit_cast(int, x), 0x121, 0xf, 0xf, false));
  return x;
}

#define XB_TMO      128
#define XB_XCNT(j)  (256  + 64 * (j))
#define XB_XSUB(j)  (1280 + 64 * (j))
#define XB_XGEN(j)  (2304 + 64 * (j))
#define XB_TOP      3328
#define XB_TOPGEN   3392
#define XCD_BAR_WORDS 3456
#define XB_SPIN_CAP (1u << 22)
DI unsigned xb_ld(unsigned* p)              { return __hip_atomic_load(p, __ATOMIC_RELAXED, __HIP_MEMORY_SCOPE_AGENT); }
DI unsigned xb_add(unsigned* p, unsigned v) { return __hip_atomic_fetch_add(p, v, __ATOMIC_RELAXED, __HIP_MEMORY_SCOPE_AGENT); }
DI unsigned xb_xcc_id() { return (unsigned)__builtin_amdgcn_s_getreg((3 << 11) | 20) & 0xFu; }
#define XB_SPIN(cond, bar) do { unsigned _sp = 0; while (cond) { __builtin_amdgcn_s_sleep(1); \
    if ((++_sp & 255u) == 0u) { if (xb_ld(&(bar)[XB_TMO])) break; if (_sp > XB_SPIN_CAP) { atomicAdd(&(bar)[XB_TMO], 1u); break; } } } } while (0)
DI void xcd_barrier_complete(unsigned* bar, unsigned x, unsigned& nloc, unsigned& nx) {
  const unsigned G = gridDim.x;
  unsigned sum, cnt, mine, sp = 0u;
  for (;;) {
    sum = 0u; cnt = 0u; mine = 0u;
#pragma unroll
    for (unsigned j = 0; j < 16; ++j) { const unsigned c = xb_ld(&bar[XB_XCNT(j)]); sum += c; cnt += (c > 0u) ? 1u : 0u; mine = (j == x) ? c : mine; }
    if (sum == G) break;
    __builtin_amdgcn_s_sleep(1);
    if ((++sp & 255u) == 0u) { if (xb_ld(&bar[XB_TMO])) break; if (sp > XB_SPIN_CAP) { atomicAdd(&bar[XB_TMO], 1u); break; } }
  }
  nloc = mine > 0u ? mine : 1u; nx = cnt > 0u ? cnt : 1u;
}
DI void xcd_barrier(unsigned* bar, volatile LAS unsigned* st) {
  asm volatile("s_waitcnt vmcnt(0)" ::: "memory");
  __syncthreads();
  if (threadIdx.x == 0) {
    const unsigned x = xb_xcc_id();
    __builtin_amdgcn_s_waitcnt(0);
    unsigned nloc = st[0], nx = st[1];
    if (nloc == 0u) { xcd_barrier_complete(bar, x, nloc, nx); st[0] = nloc; st[1] = nx; }
    const unsigned old = xb_add(&bar[XB_XSUB(x)], 1u);
    const unsigned gen = old / nloc;
    if (old + 1u == (gen + 1u) * nloc) {
      __builtin_amdgcn_fence(__ATOMIC_RELEASE, "agent");
      asm volatile("s_waitcnt vmcnt(0)" ::: "memory");
      const unsigned og = xb_add(&bar[XB_TOP], 1u);
      const unsigned tg = og / nx;
      if (og + 1u == (tg + 1u) * nx) xb_add(&bar[XB_TOPGEN], 1u);
      else XB_SPIN(xb_ld(&bar[XB_TOPGEN]) == tg, bar);
      __builtin_amdgcn_fence(__ATOMIC_ACQUIRE, "agent");
      xb_add(&bar[XB_XGEN(x)], 1u);
      asm volatile("s_waitcnt vmcnt(0)" ::: "memory");
    } else {
      XB_SPIN(xb_ld(&bar[XB_XGEN(x)]) == gen, bar);
      __builtin_amdgcn_fence(__ATOMIC_ACQUIRE, "agent");
      asm volatile("s_waitcnt vmcnt(0)" ::: "memory");
    }
  }
  __syncthreads();
}
namespace pg8 {
constexpr int BM = 256, BK = 64, HALF = 128, HTB = HALF * BK * 2, NXCD = 8, WGM = 8;
DI int lds_byte(int r, int c) { const int st = (r >> 4) * 2 + (c >> 5), rr = r & 15, cc = c & 31, ob = rr * 64 + cc * 2; return st * 1024 + (ob ^ (((ob >> 9) & 1) << 5)); }
DI void stage_rc(int b, int& R, int& C) { const int st = b / 1024, sb = b % 1024, swz = sb ^ (((sb >> 9) & 1) << 5); R = (st >> 1) * 16 + swz / 64; C = (st & 1) * 32 + (swz % 64) / 2; }
DI int perm32(int rho) { const int n = rho >> 4, i = rho & 15; return 8 * (i >> 2) + 4 * n + (i & 3); }
struct Unit { int pm, pn, which, kt0, nkt; };
struct Gemm { const bf16_t* A; const bf16_t* Bt; int M, N, K, lda, ldb; const bf16_t* A2; const bf16_t* Bt2; const bf16_t* A3; const bf16_t* Bt3; };
struct StaticOrder {
  int nM, nN, nwg, G, c, nwg2;
  DI void init(int M, int N, int G_, int c_, int n2 = 0) { nM = M / BM; nN = N / BM; nwg = nM * nN; G = G_; c = c_; nwg2 = n2; }
  DI bool next(int i, Unit& u) const {
    const long L = (long)i * G + c; u.which = 0; u.kt0 = 0; u.nkt = 0;
    if (L >= nwg) { if (L >= nwg + nwg2) return false; u.which = 1; u.pm = 0; u.pn = (int)L - nwg; return true; }
    int wgid = (int)L; { const int q = nwg / NXCD, r = nwg % NXCD, xcd = wgid % NXCD, off = wgid / NXCD; wgid = (xcd < r ? xcd * (q + 1) : r * (q + 1) + (xcd - r) * q) + off; }
    const int nig = WGM * nN, gid = wgid / nig, fm = gid * WGM, gsz = (nM - fm) < WGM ? (nM - fm) : WGM;
    u.pm = fm + ((wgid % nig) % gsz); u.pn = (wgid % nig) / gsz; return true;
  }
};

template <class Epi, class Sched>
DI void gemm_phase(LAS unsigned char* lds, const Gemm g, const Sched& S, const Epi& E) {
  int tid = threadIdx.x; asm volatile("" : "+v"(tid));
  const int wid = __builtin_amdgcn_readfirstlane(tid >> 6), lane = tid & 63, wr = wid >> 2, wc = wid & 3, fr = lane & 15, fq = lane >> 4;
  const int K = g.K, nt = K / BK;
  unsigned voffA[2], voffB[2];
#pragma unroll
  for (int i = 0; i < 2; ++i) { int R, C; stage_rc(tid * 16 + i * 8192, R, C); const int Rb = Epi::PERM ? ((R & ~31) + perm32(R & 31)) : R;
    voffA[i] = (unsigned)(R * g.lda + C) * 2u; voffB[i] = (unsigned)(Rb * g.ldb + C) * 2u; }
  const size_t kstep = (size_t)(BK * 2);
  const size_t hstepA = (size_t)HALF * g.lda * 2, hstepB = (size_t)HALF * g.ldb * 2;
  const size_t tstepA = 2 * hstepA, tstepB = 2 * hstepB;
  const unsigned ldsw = (unsigned)wid * 1024u;
#define PG8_SA(b, h) (((b) * 2 + (h)) * HTB)
#define PG8_SB(b, h) ((4 + (b) * 2 + (h)) * HTB)
#define PG8_STAGE(bufoff, gbase, voff) do { _Pragma("unroll") for (int _i = 0; _i < 2; ++_i) \
    __builtin_amdgcn_global_load_lds((const unsigned*)((const char*)(gbase) + (voff)[_i]), (LAS unsigned*)(lds + (bufoff) + ldsw + _i * 8192), 16, 0, 0); } while (0)
#define PG8_LDA(dst, b, h) do { _Pragma("unroll") for (int m = 0; m < 4; ++m) _Pragma("unroll") for (int k = 0; k < 2; ++k) dst[m][k] = *(const LAS bf16x8*)(lds + PG8_SA(b, h) + aoff + m * 2048 + k * 1024); } while (0)
#define PG8_LDB(dst, b, h) do { _Pragma("unroll") for (int n = 0; n < 2; ++n) _Pragma("unroll") for (int k = 0; k < 2; ++k) dst[n][k] = *(const LAS bf16x8*)(lds + PG8_SB(b, h) + boff + n * 2048 + k * 1024); } while (0)
#define PG8_MMA(ai, bj, At, Bt) do { __builtin_amdgcn_s_setprio(1); _Pragma("unroll") for (int m = 0; m < 4; ++m) _Pragma("unroll") for (int n = 0; n < 2; ++n) _Pragma("unroll") for (int k = 0; k < 2; ++k) \
    acc[ai][bj][m][n] = __builtin_amdgcn_mfma_f32_16x16x32_bf16(Bt[n][k], At[m][k], acc[ai][bj][m][n], 0, 0, 0); __builtin_amdgcn_s_setprio(0); } while (0)
#define PG8_WAIT_V(n) asm volatile("s_waitcnt vmcnt(" #n ")" ::: "memory")
#define PG8_WAIT_L(n) asm volatile("s_waitcnt lgkmcnt(" #n ")" ::: "memory")
#define PG8_BAR __builtin_amdgcn_s_barrier()
#define PG8_SCHED __builtin_amdgcn_sched_barrier(0)
  Unit cur, nxt; int ui = 0;
  if (!S.next(0, cur)) return;
  f32x4 acc[2][2][4][2];
#pragma unroll
  for (int a = 0; a < 2; ++a)
#pragma unroll
    for (int b = 0; b < 2; ++b)
#pragma unroll
      for (int m = 0; m < 4; ++m)
#pragma unroll
        for (int n = 0; n < 2; ++n) acc[a][b][m][n] = (f32x4){0.f, 0.f, 0.f, 0.f};
  bf16x8 At[4][2], B0[2][2], B1[2][2];
  const char* cA = (const char*)(cur.which == 0 ? g.A : (cur.which == 1 ? g.A2 : g.A3)) + (size_t)cur.pm * tstepA + (size_t)cur.kt0 * kstep; const char* cB = (const char*)(cur.which == 0 ? g.Bt : (cur.which == 1 ? g.Bt2 : g.Bt3)) + (size_t)cur.pn * tstepB + (size_t)cur.kt0 * kstep;
  PG8_STAGE(PG8_SB(0, 0), cB, voffB); PG8_STAGE(PG8_SA(0, 0), cA, voffA); PG8_STAGE(PG8_SB(0, 1), cB + hstepB, voffB); PG8_STAGE(PG8_SA(0, 1), cA + hstepA, voffA);
  if (wr == 1) PG8_BAR;
  PG8_WAIT_V(4); PG8_BAR;
  PG8_STAGE(PG8_SB(1, 0), cB + kstep, voffB); PG8_STAGE(PG8_SA(1, 0), cA + kstep, voffA); PG8_STAGE(PG8_SB(1, 1), cB + hstepB + kstep, voffB);
  PG8_WAIT_V(6); PG8_BAR;
  for (;;) {
    int t3 = threadIdx.x; asm volatile("" : "+v"(t3));
    const int aoff = lds_byte(wr * 64 + (t3 & 15), ((t3 & 63) >> 4) * 8), boff = lds_byte(wc * 32 + (t3 & 15), ((t3 & 63) >> 4) * 8);
    const bool has_next = S.next(ui + 1, nxt);
    const char* nA = has_next ? (const char*)(nxt.which == 0 ? g.A : (nxt.which == 1 ? g.A2 : g.A3)) + (size_t)nxt.pm * tstepA + (size_t)nxt.kt0 * kstep : cA; const char* nB = has_next ? (const char*)(nxt.which == 0 ? g.Bt : (nxt.which == 1 ? g.Bt2 : g.Bt3)) + (size_t)nxt.pn * tstepB + (size_t)nxt.kt0 * kstep : cB;
    const int ntu = cur.nkt > 0 ? cur.nkt : nt;
    for (int t = 0; t < ntu; t += 2) {
      const bool last = (t == ntu - 2);
      const char* a1 = cA + (size_t)(t + 1) * kstep;
      const char* a2 = last ? nA : cA + (size_t)(t + 2) * kstep; const char* b2 = last ? nB : cB + (size_t)(t + 2) * kstep;
      const char* a3 = a2 + kstep; const char* b3 = b2 + kstep;
      PG8_LDB(B0, 0, 0); PG8_SCHED; PG8_LDA(At, 0, 0); PG8_STAGE(PG8_SA(1, 1), a1 + hstepA, voffA);
      PG8_WAIT_L(8); PG8_BAR; PG8_WAIT_L(0); PG8_MMA(0, 0, At, B0); PG8_BAR; PG8_SCHED;
      PG8_LDB(B1, 0, 1); PG8_STAGE(PG8_SB(0, 0), b2, voffB);
      PG8_BAR; PG8_WAIT_L(0); PG8_MMA(0, 1, At, B1); PG8_BAR;
      PG8_LDA(At, 0, 1); PG8_STAGE(PG8_SA(0, 0), a2, voffA);
      PG8_BAR; PG8_WAIT_L(0); PG8_MMA(1, 0, At, B0); PG8_BAR; PG8_SCHED;
      PG8_STAGE(PG8_SB(0, 1), b2 + hstepB, voffB);
      PG8_WAIT_V(6); PG8_BAR; PG8_MMA(1, 1, At, B1); PG8_BAR;
      PG8_LDB(B0, 1, 0); PG8_SCHED; PG8_LDA(At, 1, 0); PG8_STAGE(PG8_SA(0, 1), a2 + hstepA, voffA);
      PG8_WAIT_L(8); PG8_BAR; PG8_WAIT_L(0); PG8_MMA(0, 0, At, B0); PG8_BAR; PG8_SCHED;
      PG8_LDB(B1, 1, 1); PG8_STAGE(PG8_SB(1, 0), b3, voffB);
      PG8_BAR; PG8_WAIT_L(0); PG8_MMA(0, 1, At, B1); PG8_BAR;
      PG8_LDA(At, 1, 1); PG8_STAGE(PG8_SA(1, 0), a3, voffA);
      PG8_BAR; PG8_WAIT_L(0); PG8_MMA(1, 0, At, B0); PG8_BAR; PG8_SCHED;
      PG8_STAGE(PG8_SB(1, 1), b3 + hstepB, voffB);
      PG8_WAIT_V(6); PG8_BAR; PG8_MMA(1, 1, At, B1); PG8_BAR;
    }
    { int t2 = threadIdx.x; asm volatile("" : "+v"(t2)); const int w2 = __builtin_amdgcn_readfirstlane(t2 >> 6), l2 = t2 & 63; E(acc, cur, w2 >> 2, w2 & 3, l2 & 15, l2 >> 4); }
    if (!has_next) break;
    if (!Epi::CHAIN || nxt.which == 0 || nxt.pm >= 64) {
#pragma unroll
    for (int a = 0; a < 2; ++a)
#pragma unroll
      for (int b = 0; b < 2; ++b)
#pragma unroll
        for (int m = 0; m < 4; ++m)
#pragma unroll
          for (int n = 0; n < 2; ++n) acc[a][b][m][n] = (f32x4){0.f, 0.f, 0.f, 0.f};
    }
    cur = nxt; cA = nA; cB = nB; ++ui;
  }
  PG8_WAIT_V(0);
  if (wr == 0) PG8_BAR;
  PG8_BAR;
#undef PG8_SA
#undef PG8_SB
#undef PG8_STAGE
#undef PG8_LDA
#undef PG8_LDB
#undef PG8_MMA
#undef PG8_WAIT_V
#undef PG8_WAIT_L
#undef PG8_BAR
#undef PG8_SCHED
}
typedef f32x4 Acc[2][2][4][2];

template <class F>
DI void store_perm(const f32x4 (&acc)[2][2][4][2], bf16_t* O, int ldc, int rowt, int colt, int wr, int wc, int fr, int fq, const F& f, bool skip_bj1) {
  const int row0 = rowt + wr * 64 + fr, col0 = colt + wc * 32 + 8 * fq;
#pragma unroll
  for (int ai = 0; ai < 2; ++ai)
#pragma unroll
    for (int m = 0; m < 4; ++m) { bf16_t* rowp = O + (size_t)(row0 + ai * HALF + m * 16) * ldc + col0;
#pragma unroll
      for (int bj = 0; bj < 2; ++bj) { if (bj == 1 && skip_bj1) continue;
        const f32x4 v0 = acc[ai][bj][m][0], v1 = acc[ai][bj][m][1];
        u32x4 w; w.x = pk2(f(v0[0], bj, 0), f(v0[1], bj, 1)); w.y = pk2(f(v0[2], bj, 2), f(v0[3], bj, 3)); w.z = pk2(f(v1[0], bj, 4), f(v1[1], bj, 5)); w.w = pk2(f(v1[2], bj, 6), f(v1[3], bj, 7));
        *(u32x4*)(rowp + bj * HALF) = w; }
      asm volatile("" ::: "memory"); }
}

struct EpiPlain {
  static constexpr bool PERM = true, CHAIN = false;
  bf16_t* O; int ldc;
  DI void operator()(const f32x4 (&acc)[2][2][4][2], const Unit& u, int wr, int wc, int fr, int fq) const {
    store_perm(acc, O, ldc, u.pm * BM, u.pn * BM, wr, wc, fr, fq, [](float v, int, int) { return v; }, false);
  }
};
struct EpiIn {
  static constexpr bool PERM = true, CHAIN = false;
  unsigned char* ws;
  DI void operator()(const f32x4 (&acc)[2][2][4][2], const Unit& u, int wr, int wc, int fr, int fq) const {
    const int pn = u.pn, rowt = u.pm * BM;
    size_t off; int ld, colt, act = 0;
    if (u.which) { off = WS_VT; ld = NTOK; colt = pn * 256; }
    else if (pn < 12) { off = pn < 4 ? WS_AB : pn < 8 ? WS_AC : WS_AX; ld = 1024; colt = (pn & 3) * 256; }
    else if (pn < 24) { off = WS_RKV; ld = 3072; colt = (pn - 12) * 256; }
    else if (pn == 24) { off = WS_LACT; ld = 512; colt = 0; act = 1; }
    else if (pn == 25) { off = WS_LACT; ld = 512; colt = 256; act = 2; }
    else if (pn < 30) { off = WS_Q; ld = 1024; colt = (pn - 26) * 256; }
    else if (pn == 30) { off = WS_K; ld = 256; colt = 0; }
    else { off = WS_GATES; ld = 3072; colt = (pn - 31) * 256; act = 3; }
    if (act == 0) store_perm(acc, (bf16_t*)(ws + off), ld, rowt, colt, wr, wc, fr, fq, [](float v, int, int) { return v; }, false);
    else store_perm(acc, (bf16_t*)(ws + off), ld, rowt, colt, wr, wc, fr, fq, [act](float v, int bj, int) { const bool th = act == 1 && bj == 0; const float sg = sigmoidf_(th ? 2.0f * v : v); return (act == 1 && bj == 1) ? v : (th ? 2.0f * sg - 1.0f : sg); }, act == 2);
  }
};
struct LoraOrder {
  StaticOrder S;
  DI bool next(int i, Unit& u) const { if (!S.next(i, u)) return false; const int grp = u.pn >> 2; u.kt0 = grp < 2 ? 0 : (grp < 4 ? 2 : 4); u.nkt = 2; return true; }
};
struct EpiLora {
  static constexpr bool PERM = true, CHAIN = false;
  unsigned char* ws; const float* w0; const float* a0;
  DI void operator()(const f32x4 (&acc)[2][2][4][2], const Unit& u, int wr, int wc, int fr, int fq) const {
    const int grp = u.pn >> 2, colt = (u.pn & 3) * 256, rowt = u.pm * BM;
    bf16_t* O = (bf16_t*)(ws + WS_LOUT + (size_t)grp * SZ16);
    const int cbase = colt + wc * 32 + 8 * fq;
    if (grp < 4) { const float* bp = (grp < 2 ? w0 + grp * 1024 : a0 + (grp - 2) * 1024) + cbase; const float sc = grp < 2 ? 0.60653066f : 1.0f;
      const f32x4 b00 = *(const f32x4*)bp, b01 = *(const f32x4*)(bp + 4), b10 = *(const f32x4*)(bp + HALF), b11 = *(const f32x4*)(bp + HALF + 4);
      store_perm(acc, O, 1024, rowt, colt, wr, wc, fr, fq, [=](float v, int bj, int j) { const float bb = bj ? (j < 4 ? b10[j & 3] : b11[j & 3]) : (j < 4 ? b00[j & 3] : b01[j & 3]); return sc * sigmoidf_(v + bb); }, false); }
    else store_perm(acc, O, 1024, rowt, colt, wr, wc, fr, fq, [](float v, int, int) { return v; }, false);
  }
};
struct MergeOrder {
  StaticOrder S; int nctx;
  DI bool next(int i, Unit& u) const {
    const int R = (S.nwg + S.G - 1) / S.G;
    if (i < 3 * R) { if (!S.next(i / 3, u)) return false; u.which = i % 3; return true; }
    const int e = (i - 3 * R) * S.G + S.c; if (e >= nctx) return false;
    const int tile = e / 3;
    u.pm = 64 + (tile >> 2); u.pn = tile & 3; u.which = e - 3 * tile; u.kt0 = 0; u.nkt = 0; return true;
  }
};
struct EpiMergeChain {
  static constexpr bool PERM = true, CHAIN = true;
  unsigned char* ws;
  DI void operator()(f32x4 (&acc)[2][2][4][2], const Unit& u, int wr, int wc, int fr, int fq) const {
    const int row0 = u.pm * BM + wr * 64 + fr, col0 = u.pn * BM + wc * 32 + 8 * fq, br = u.which;
    const bf16_t* G = (const bf16_t*)(ws + WS_GATES) + br * 1024; bf16_t* M16 = (bf16_t*)(ws + WS_YB2);
    const bool isctx = u.pm >= 64;
    float* MP = (float*)(ws + WS_CPART) + (size_t)br * NTC * 1024 - (size_t)NTL * 1024;
#pragma unroll
    for (int ai = 0; ai < 2; ++ai)
#pragma unroll
      for (int m = 0; m < 4; ++m) { const size_t row = (size_t)(row0 + ai * HALF + m * 16);
#pragma unroll
        for (int bj = 0; bj < 2; ++bj) { const int c = col0 + bj * HALF;
          float f[8]; unpack8(*(const u32x4*)(G + row * 3072 + c), f);
          if (br < 2 && !isctx) { float h[8]; unpack8(*(const u32x4*)(G + row * 3072 + 1024 + c), h);
#pragma unroll
            for (int j = 0; j < 8; ++j) f[j] *= __builtin_amdgcn_rcpf(h[j]); }
          acc[ai][bj][m][0] *= (f32x4){f[0], f[1], f[2], f[3]}; acc[ai][bj][m][1] *= (f32x4){f[4], f[5], f[6], f[7]};
          if (isctx) { float* q = MP + row * 1024 + c; *(f32x4*)q = acc[ai][bj][m][0]; *(f32x4*)(q + 4) = acc[ai][bj][m][1]; }
          else if (br == 2) { const f32x4 v0 = acc[ai][bj][m][0], v1 = acc[ai][bj][m][1]; u32x4 w; w.x = pk2(v0[0], v0[1]); w.y = pk2(v0[2], v0[3]); w.z = pk2(v1[0], v1[1]); w.w = pk2(v1[2], v1[3]);
            *(u32x4*)(M16 + row * 1024 + c) = w; } }
        asm volatile("" ::: "memory"); }
  }
};
struct ResOrder {
  StaticOrder S; int nsplit, ks, nktq;
  DI bool next(int i, Unit& u) const {
    const long L = (long)i * S.G + S.c;
    int pm, pn, which = 0, kt0 = 0, nkt = 0;
    if (L < S.nwg) {
      int wgid = (int)L; { const int q = S.nwg / NXCD, r = S.nwg % NXCD, xcd = wgid % NXCD, off = wgid / NXCD; wgid = (xcd < r ? xcd * (q + 1) : r * (q + 1) + (xcd - r) * q) + off; }
      const int nig = WGM * S.nN, gid = wgid / nig, fm = gid * WGM, gsz = (S.nM - fm) < WGM ? (S.nM - fm) : WGM;
      pm = fm + ((wgid % nig) % gsz); pn = (wgid % nig) / gsz;
    } else {
      const int e = (int)L - S.nwg; if (e >= nsplit) return false;
      const int tile = e / ks, part = e - tile * ks;
      pm = 64 + (tile >> 2); pn = tile & 3; which = 1; kt0 = part * nktq; nkt = nktq;
    }
    u.pm = pm; u.pn = pn; u.which = which; u.kt0 = kt0; u.nkt = nkt; return true;
  }
};
struct EpiRes {
  static constexpr bool PERM = true, CHAIN = false;
  const float* baseL; const float* baseC; float* outL; float* outC; const float* mod;
  float* cpart; int nktq;
  DI void operator()(const f32x4 (&acc)[2][2][4][2], const Unit& u, int wr, int wc, int fr, int fq) const {
    const bool isc = u.pm >= 64; const int r3 = u.pm < 32 ? 0 : (u.pm < 64 ? 1 : 2);
    const float* base = isc ? baseC - (size_t)NTL * 1024 : baseL; float* out = isc ? outC - (size_t)NTL * 1024 : outL;
    const int row0 = u.pm * BM + wr * 64 + fr, col0 = u.pn * BM + wc * 32 + 8 * fq;
    const float* mv = mod + r3 * 6144;
    f32x4 g[2][2];
#pragma unroll
    for (int bj = 0; bj < 2; ++bj)
#pragma unroll
      for (int n = 0; n < 2; ++n) g[bj][n] = *(const f32x4*)(mv + col0 + bj * HALF + 4 * n);
#pragma unroll
    for (int ai = 0; ai < 2; ++ai)
#pragma unroll
      for (int m = 0; m < 4; ++m) { const size_t off = (size_t)(row0 + ai * HALF + m * 16) * 1024;
#pragma unroll
        for (int bj = 0; bj < 2; ++bj)
#pragma unroll
          for (int n = 0; n < 2; ++n) { const int c = col0 + bj * HALF + 4 * n;
            const f32x4 v = g[bj][n] * acc[ai][bj][m][n];
            if (u.which) { *(f32x4*)(cpart + (size_t)(u.kt0 / nktq) * NTC * 1024 + (off - (size_t)NTL * 1024) + c) = v; }
            else { const f32x4 b = *(const f32x4*)(base + off + c); *(f32x4*)(out + off + c) = b + v; } }
        asm volatile("" ::: "memory"); }
  }
};
}
struct Ctx { int tid, lane, wave, bid, nb; unsigned char* lds; };

DI void conv_tile(const Ctx& c, bf16_t* dst, int ldd, const float* src, int ldsrc) {
  float* t = (float*)c.lds;
  if (src) {
#pragma unroll
    for (int i = 0; i < 8; ++i) { const int e = c.tid + i * NTHR, kk = e >> 6, nn = e & 63; t[kk * 65 + nn] = src[(size_t)kk * ldsrc + nn]; }
  }
  __syncthreads();
#pragma unroll
  for (int i = 0; i < 4; ++i) { const int e = c.tid + i * NTHR, nn = e >> 5, kp = e & 31;
    unsigned w = 0u; if (src) w = pk2(t[(2 * kp) * 65 + nn], t[(2 * kp + 1) * 65 + nn]);
    *(unsigned*)(dst + (size_t)nn * ldd + 2 * kp) = w; }
  __syncthreads();
}
DI void phase_convert(const Ctx& c, PP p, int l) {
  unsigned char* ws = p->ws;
  for (int t = c.bid; t < 6432; t += c.nb) {
    if (t < 2816) { const int nt = t >> 4, kt = t & 15; const int n0 = nt * 64, k0 = kt * 64;
      const float* W = p->in[7] + (size_t)l * 1024 * NIN;
      bf16_t* dst; int srccol;
      if (n0 < 6528) { dst = (bf16_t*)(ws + WS_WIN) + (size_t)n0 * 1024; srccol = n0; }
      else if (n0 < 6656) { dst = (bf16_t*)(ws + WS_WIN) + (size_t)n0 * 1024; srccol = -1; }
      else if (n0 < 7936) { dst = (bf16_t*)(ws + WS_WIN) + (size_t)n0 * 1024; srccol = n0 - 128; }
      else if (n0 < 11008) { dst = (bf16_t*)(ws + WS_WIN) + (size_t)n0 * 1024; srccol = n0 - 7936 + 8064; }
      else { dst = (bf16_t*)(ws + WS_WV) + (size_t)(n0 - 11008) * 1024; srccol = n0 - 11008 + 7808; }
      conv_tile(c, dst + k0, 1024, srccol < 0 ? nullptr : W + (size_t)k0 * NIN + srccol, NIN);
    } else if (t < 3296) { const int u = t - 2816, nt = u / 6, kt = u % 6; const int n0 = nt * 64, k0 = kt * 64, grp = n0 >> 10, nc = n0 & 1023;
      const float* src = nullptr;
      if (grp < 2) { if (kt == grp) src = p->in[12] + ((size_t)(l * 2 + grp) * 64) * 1024 + nc; }
      else if (grp < 4) { if (kt == grp) src = p->in[14] + ((size_t)(l * 2 + grp - 2) * 64) * 1024 + nc; }
      else { if (kt >= 4) src = p->in[15] + ((size_t)l * 128 + (kt - 4) * 64) * 1024 + nc; }
      conv_tile(c, (bf16_t*)(ws + WS_WLORA) + (size_t)n0 * 384 + k0, 384, src, 1024);
    } else if (t < 4320) { const int u = t - 3296, which = u >> 8, v = u & 255, nt = v >> 4, kt = v & 15;
      const int idx = which == 0 ? 9 : which == 1 ? 21 : which == 2 ? 23 : 24;
      const float* W = p->in[idx] + (size_t)l * 1024 * 1024;
      conv_tile(c, (bf16_t*)(ws + WS_WA + (size_t)which * AL((size_t)1024 * 1024 * 2)) + (size_t)(nt * 64) * 1024 + kt * 64, 1024, W + (size_t)(kt * 64) * 1024 + nt * 64, 1024);
    } else if (t < 5728) { const int u = t - 4320, nt = u >> 4, kt = u & 15;
      const float* W = p->in[26] + (size_t)l * 1024 * 5632;
      conv_tile(c, (bf16_t*)(ws + WS_WUP) + (size_t)(nt * 64) * 1024 + kt * 64, 1024, W + (size_t)(kt * 64) * 5632 + nt * 64, 5632);
    } else { const int u = t - 5728, nt = u / 44, kt = u % 44;
      const float* W = p->in[28] + (size_t)l * 2816 * 1024;
      conv_tile(c, (bf16_t*)(ws + WS_WDN) + (size_t)(nt * 64) * 2816 + kt * 64, 2816, W + (size_t)(kt * 64) * 1024 + nt * 64, 1024);
    }
  }
}

DI void phase_mods(const Ctx& c, PP p) {
  float* s = (float*)c.lds;
  float* red = s + 3 * 1024;
  for (int i = c.tid; i < 3072; i += NTHR) { const float v = i < 2048 ? p->in[1][i] : p->in[3][i - 2048]; s[i] = v * sigmoidf_(v); }
  __syncthreads();
  float* mod = (float*)(p->ws + WS_MOD);
  const int col = c.tid & 63, kg = c.tid >> 6;
  for (int it = c.bid; it < DEPTH * 96; it += c.nb) {
    const int l = it / 96, j0 = (it % 96) * 64;
    const float* W = p->in[4] + (size_t)l * 1024 * 6144 + j0 + col;
    float a0 = 0.f, a1 = 0.f, a2 = 0.f;
#pragma unroll 8
    for (int k = kg * 128; k < kg * 128 + 128; ++k) { const float w = W[(size_t)k * 6144]; a0 += s[k] * w; a1 += s[1024 + k] * w; a2 += s[2048 + k] * w; }
    red[(kg * 3 + 0) * 64 + col] = a0; red[(kg * 3 + 1) * 64 + col] = a1; red[(kg * 3 + 2) * 64 + col] = a2;
    __syncthreads();
    if (c.tid < 192) { const int r = c.tid >> 6; float v = p->in[5][(size_t)l * 6144 + j0 + col];
#pragma unroll
      for (int g = 0; g < 8; ++g) v += red[(g * 3 + r) * 64 + col];
      mod[((size_t)l * 3 + r) * 6144 + j0 + col] = v; }
    __syncthreads();
  }
  { float* xcd = (float*)(p->ws + WS_XC); const float* cx = p->in[2];
    for (int i = c.bid * NTHR + c.tid; i < NTC * 1024 / 4; i += c.nb * NTHR) ((f32x4*)xcd)[i] = ((const f32x4*)cx)[i]; }
  const int gt = c.bid * NTHR + c.tid;
  if (gt < 2048) { const int pos = gt >> 4, f = gt & 15; const float inv = powf(10000.0f, -(float)f / 16.0f); const float ang = (float)pos * inv;
    float* rope = (float*)(p->ws + WS_ROPE); rope[gt] = cosf(ang); rope[2048 + gt] = sinf(ang); }
}

DI void phase_norm(const Ctx& c, PP p, const float* xL, float* xC, const float* g, const float* mod  , int shift_idx, int npart) {
  const float* cpart = (const float*)(p->ws + WS_CPART);
  bf16_t* H = (bf16_t*)(p->ws + WS_H);
  for (int row = c.bid * 8 + c.wave; row < NTOK; row += c.nb * 8) {
    const float* xr = row < NTL ? xL + (size_t)row * 1024 : xC + (size_t)(row - NTL) * 1024;
    const int r3 = row < SEQ ? 0 : (row < NTL ? 1 : 2);
    const float* sh = mod + r3 * 6144 + shift_idx * 1024; const float* sc = sh + 1024;
    f32x4 v[4]; float ss = 0.f;
#pragma unroll
    for (int i = 0; i < 4; ++i) { v[i] = *(const f32x4*)(xr + i * 256 + c.lane * 4);
      if (row >= NTL && npart > 0) {
        for (int q = 0; q < npart; ++q) v[i] += *(const f32x4*)(cpart + ((size_t)q * NTC + (row - NTL)) * 1024 + i * 256 + c.lane * 4);
        *(f32x4*)(xC + (size_t)(row - NTL) * 1024 + i * 256 + c.lane * 4) = v[i]; }
      ss += v[i][0] * v[i][0] + v[i][1] * v[i][1] + v[i][2] * v[i][2] + v[i][3] * v[i][3]; }
    ss = wave_sum(ss);
    const float rs = rsqrtf(ss * (1.0f / 1024.0f) + 1e-6f);
#pragma unroll
    for (int i = 0; i < 4; ++i) { const int col = i * 256 + c.lane * 4;
      const f32x4 gg = *(const f32x4*)(g + col), s1 = *(const f32x4*)(sc + col), s0 = *(const f32x4*)(sh + col);
      const f32x4 h = v[i] * rs * gg * (1.0f + s1) + s0;
      u32x2 w; w.x = pk2(h[0], h[1]); w.y = pk2(h[2], h[3]); *(u32x2*)(H + (size_t)row * 1024 + col) = w; }
  }
}

DI void phase_final(const Ctx& c, PP p, float dpert) {
  const float* g = p->in[29];
  for (int row = c.bid * 8 + c.wave; row < NTL; row += c.nb * 8) {
    float* xr = p->out + (size_t)row * 1024;
    f32x4 v[4]; float ss = 0.f;
#pragma unroll
    for (int i = 0; i < 4; ++i) { v[i] = *(const f32x4*)(xr + i * 256 + c.lane * 4); ss += v[i][0] * v[i][0] + v[i][1] * v[i][1] + v[i][2] * v[i][2] + v[i][3] * v[i][3]; }
    ss = wave_sum(ss);
    const float rs = rsqrtf(ss * (1.0f / 1024.0f) + 1e-6f);
#pragma unroll
    for (int i = 0; i < 4; ++i) { const int col = i * 256 + c.lane * 4; const float sg = (row & 1) ? dpert : -dpert; *(f32x4*)(xr + col) = v[i] * rs * *(const f32x4*)(g + col) + (f32x4){sg, -sg, sg, -sg}; }
  }
}

DI void ld8f(const float* p, float (&f)[8]) { const f32x4 a = *(const f32x4*)p, b = *(const f32x4*)(p + 4); f[0] = a[0]; f[1] = a[1]; f[2] = a[2]; f[3] = a[3]; f[4] = b[0]; f[5] = b[1]; f[6] = b[2]; f[7] = b[3]; }
DI void seq_of_row(int row0, int& pos0, int& seqlen) { if (row0 < NTL) { pos0 = row0 & (SEQ - 1); seqlen = SEQ; } else { pos0 = (row0 - NTL) & (CTXL - 1); seqlen = CTXL; } }

DI void phase_conv_a(const Ctx& c, PP p, int l) {
  bf16_t* AB = (bf16_t*)(p->ws + WS_AB); const bf16_t* AC = (const bf16_t*)(p->ws + WS_AC); const bf16_t* AX = (const bf16_t*)(p->ws + WS_AX);
  const float* cw = p->in[8] + (size_t)l * 3 * 1024;
  const int nitems = (NTOK / 8) * 128;
  for (int it = c.bid * NTHR + c.tid; it < nitems; it += c.nb * NTHR) {
    const int rb = it >> 7, ch = it & 127, row0 = rb * 8, col = ch * 8; int pos0, seqlen; seq_of_row(row0, pos0, seqlen);
    float w0[8], w1[8], w2[8];
#pragma unroll
    for (int j = 0; j < 8; ++j) { w0[j] = cw[col + j]; w1[j] = cw[1024 + col + j]; w2[j] = cw[2048 + col + j]; }
    float zp[8], zc[8], zn[8];
    auto loadz = [&](int row, float (&z)[8]) { float a[8], b[8]; unpack8(*(const u32x4*)(AC + (size_t)row * 1024 + col), a); unpack8(*(const u32x4*)(AX + (size_t)row * 1024 + col), b);
#pragma unroll
      for (int j = 0; j < 8; ++j) z[j] = a[j] * b[j]; };
    if (pos0 > 0) loadz(row0 - 1, zp); else {
#pragma unroll
      for (int j = 0; j < 8; ++j) zp[j] = 0.f; }
    loadz(row0, zc);
#pragma unroll
    for (int r = 0; r < 8; ++r) {
      if (pos0 + r + 1 < seqlen) loadz(row0 + r + 1, zn); else {
#pragma unroll
        for (int j = 0; j < 8; ++j) zn[j] = 0.f; }
      float b[8]; unpack8(*(const u32x4*)(AB + (size_t)(row0 + r) * 1024 + col), b);
      float o[8];
#pragma unroll
      for (int j = 0; j < 8; ++j) { o[j] = b[j] * (zp[j] * w0[j] + zc[j] * w1[j] + zn[j] * w2[j]); zp[j] = zc[j]; zc[j] = zn[j]; }
      u32x4 w; w.x = pk2(o[0], o[1]); w.y = pk2(o[2], o[3]); w.z = pk2(o[4], o[5]); w.w = pk2(o[6], o[7]);
      *(u32x4*)(AB + (size_t)(row0 + r) * 1024 + col) = w;
    }
  }
}

DI void phase_ffn_act(const Ctx& c, PP p, int l) {
  const bf16_t* U = (const bf16_t*)(p->ws + WS_U); bf16_t* ACT = (bf16_t*)(p->ws + WS_GATES);
  const float* cw = p->in[27] + (size_t)l * 3 * 5632;
  const int nrows = (l == DEPTH - 1) ? NTL : NTOK;
  const int nitems = (nrows / 8) * 352;
  for (int it = c.bid * NTHR + c.tid; it < nitems; it += c.nb * NTHR) {
    const int rb = it / 352, ch = it % 352, row0 = rb * 8, col = ch * 8; int pos0, seqlen; seq_of_row(row0, pos0, seqlen);
    const bool hp = pos0 > 0, hn = pos0 + 8 < seqlen;
    u32x4 rg[10], rv[10];
#pragma unroll
    for (int r = 0; r < 10; ++r) { int row = row0 - 1 + r; row = (r == 0 && !hp) ? row0 : row; row = (r == 9 && !hn) ? row0 + 7 : row;
      rg[r] = *(const u32x4*)(U + (size_t)row * 5632 + col); rv[r] = *(const u32x4*)(U + (size_t)row * 5632 + 2816 + col); }
    if (!hp) { rg[0] = (u32x4){0u, 0u, 0u, 0u}; rv[0] = rg[0]; }
    if (!hn) { rg[9] = (u32x4){0u, 0u, 0u, 0u}; rv[9] = rg[9]; }
    float wg[3][8], wv[3][8];
#pragma unroll
    for (int i = 0; i < 3; ++i) { ld8f(cw + i * 5632 + col, wg[i]); ld8f(cw + i * 5632 + 2816 + col, wv[i]); }
    float gp[8], gc[8], gn[8], vp[8], vc[8], vn[8];
    unpack8(rg[0], gp); unpack8(rv[0], vp); unpack8(rg[1], gc); unpack8(rv[1], vc);
#pragma unroll
    for (int r = 0; r < 8; ++r) {
      unpack8(rg[r + 2], gn); unpack8(rv[r + 2], vn);
      float o[8];
#pragma unroll
      for (int j = 0; j < 8; ++j) {
        const float ug = gp[j] * wg[0][j] + gc[j] * wg[1][j] + gn[j] * wg[2][j];
        const float uv = vp[j] * wv[0][j] + vc[j] * wv[1][j] + vn[j] * wv[2][j];
        o[j] = ug * sigmoidf_(ug) * uv; gp[j] = gc[j]; gc[j] = gn[j]; vp[j] = vc[j]; vc[j] = vn[j]; }
      u32x4 w; w.x = pk2(o[0], o[1]); w.y = pk2(o[2], o[3]); w.z = pk2(o[4], o[5]); w.w = pk2(o[6], o[7]);
      *(u32x4*)(ACT + (size_t)(row0 + r) * 2816 + col) = w;
    }
  }
}

DI float red8(float x) {
  x += __builtin_bit_cast(float, __builtin_amdgcn_update_dpp(0, __builtin_bit_cast(int, x), 0xB1, 0xf, 0xf, false));
  x += __builtin_bit_cast(float, __builtin_amdgcn_update_dpp(0, __builtin_bit_cast(int, x), 0x4E, 0xf, 0xf, false));
  x += __builtin_bit_cast(float, __builtin_amdgcn_update_dpp(0, __builtin_bit_cast(int, x), 0x141, 0xf, 0xf, false));
  return x;
}
DI void phase_rwkv_fin(const Ctx& c, PP p, int l) {
  bf16_t* YF = (bf16_t*)(p->ws + WS_H); const bf16_t* YB = (const bf16_t*)(p->ws + WS_YB2); const bf16_t* RKV = (const bf16_t*)(p->ws + WS_RKV);
  const bf16_t* AS0 = (const bf16_t*)(p->ws + WS_LOUT + 2 * SZ16); const bf16_t* AS1 = (const bf16_t*)(p->ws + WS_LOUT + 3 * SZ16); const bf16_t* GG = (const bf16_t*)(p->ws + WS_LOUT + 4 * SZ16);
  const int gw = c.bid * 8 + c.wave, half = gw & 1, ch0 = half * 512 + c.lane * 8;
  float m0[3][8], m1[3][8], kav[8], rkv_[8], lgv[8], lbv[8];
  { const float* mu = p->in[10] + (size_t)l * 2 * 3072;
#pragma unroll
    for (int q = 0; q < 3; ++q) { ld8f(mu + q * 1024 + ch0, m0[q]); ld8f(mu + 3072 + q * 1024 + ch0, m1[q]); }
    ld8f(p->in[17] + (size_t)l * 1024 + ch0, kav); ld8f(p->in[18] + (size_t)l * 1024 + ch0, rkv_); ld8f(p->in[19] + (size_t)l * 1024 + ch0, lgv); ld8f(p->in[20] + (size_t)l * 1024 + ch0, lbv); }
  const int ntok = (l == DEPTH - 1) ? NTL : NTOK;
  for (int row = gw >> 1; row < ntok; row += c.nb * 4) {
    int pos, seqlen; seq_of_row(row, pos, seqlen);
    const float mp = pos > 0 ? 1.f : 0.f, mn = pos + 1 < seqlen ? 1.f : 0.f;
    const bf16_t* r0 = RKV + (size_t)(pos > 0 ? row - 1 : row) * 3072 + ch0; const bf16_t* r1 = RKV + (size_t)row * 3072 + ch0; const bf16_t* r2 = RKV + (size_t)(pos + 1 < seqlen ? row + 1 : row) * 3072 + ch0;
    float x[3][8];
#pragma unroll
    for (int q = 0; q < 3; ++q) { float a[8], b[8], d[8]; unpack8(*(const u32x4*)(r0 + q * 1024), a); unpack8(*(const u32x4*)(r1 + q * 1024), b); unpack8(*(const u32x4*)(r2 + q * 1024), d);
#pragma unroll
      for (int j = 0; j < 8; ++j) x[q][j] = mp * m0[q][j] * a[j] + (1.0f - m0[q][j] - m1[q][j]) * b[j] + mn * m1[q][j] * d[j]; }
    const size_t o = (size_t)row * 1024 + ch0;
    float a0[8], a1[8], yf[8], yb[8], gg[8];
    unpack8(*(const u32x4*)(AS0 + o), a0); unpack8(*(const u32x4*)(AS1 + o), a1); unpack8(*(const u32x4*)(YF + o), yf); unpack8(*(const u32x4*)(YB + o), yb); unpack8(*(const u32x4*)(GG + o), gg);
    float s01 = 0.f, sy = 0.f, y[8];
#pragma unroll
    for (int j = 0; j < 8; ++j) { const float kd0 = x[1][j] * (1.0f + (a0[j] - 1.0f) * kav[j]), kd1 = x[1][j] * (1.0f + (a1[j] - 1.0f) * kav[j]);
      s01 += x[0][j] * rkv_[j] * (kd0 + kd1); y[j] = yf[j] + yb[j]; sy += y[j]; }
    s01 = red8(s01); sy = red8(sy);
    const float mean = sy * (1.0f / 64.0f); float sq = 0.f;
#pragma unroll
    for (int j = 0; j < 8; ++j) { y[j] -= mean; sq += y[j] * y[j]; }
    sq = red8(sq);
    const float rstd = rsqrtf(sq * (1.0f / 64.0f) + 64e-5f);
    float ov[8];
#pragma unroll
    for (int j = 0; j < 8; ++j) ov[j] = (y[j] * rstd * lgv[j] + lbv[j] + s01 * x[2][j]) * gg[j];
    u32x4 w; w.x = pk2(ov[0], ov[1]); w.y = pk2(ov[2], ov[3]); w.z = pk2(ov[4], ov[5]); w.w = pk2(ov[6], ov[7]);
    *(u32x4*)(YF + o) = w;
  }
}

DI void phase_mctx(const Ctx& c, PP p) {
  const float* MP = (const float*)(p->ws + WS_CPART); bf16_t* M16 = (bf16_t*)(p->ws + WS_YB2) + (size_t)NTL * 1024;
  for (int i = c.bid * NTHR + c.tid; i < NTC * 1024 / 4; i += c.nb * NTHR) {
    const f32x4 v = *(const f32x4*)(MP + (size_t)i * 4) + *(const f32x4*)(MP + (size_t)NTC * 1024 + (size_t)i * 4) + *(const f32x4*)(MP + (size_t)2 * NTC * 1024 + (size_t)i * 4);
    u32x2 w; w.x = pk2(v[0], v[1]); w.y = pk2(v[2], v[3]); *(u32x2*)(M16 + (size_t)i * 4) = w;
  }
}
#define MFMA32(a, b, c) __builtin_amdgcn_mfma_f32_32x32x16_bf16((a), (b), (c), 0, 0, 0)
constexpr int KS_LD = 72, VS_LD = 136;
constexpr float QSCALE = 0.125f * 1.4426950408889634f;

DI void attn_unit(const Ctx& c, PP p, int l, int unit) {
  bf16_t* Ks = (bf16_t*)c.lds; bf16_t* Vs = Ks + 128 * KS_LD;
  const bf16_t* Q = (const bf16_t*)(p->ws + WS_Q); const bf16_t* Kg = (const bf16_t*)(p->ws + WS_K); const bf16_t* Vt = (const bf16_t*)(p->ws + WS_VT);
  bf16_t* O = (bf16_t*)(p->ws + WS_Q);
  const float* ropec = (const float*)(p->ws + WS_ROPE); const float* ropes = ropec + 2048;
  const bool isctx = unit >= 512;
  int b, n, g, qrow0;
  if (!isctx) { b = unit >> 8; n = (unit >> 2) & 63; g = unit & 3; qrow0 = b * SEQ + n * 128; }
  else { const int uu = unit - 512; b = uu >> 3; n = (uu >> 2) & 1; g = uu & 3; qrow0 = NTL + b * CTXL + n * 128; }
  const int lane = c.lane, w = c.wave, r = lane & 31, h = lane >> 5;
  const int head = 4 * g + (w >> 1), qoff = 64 * (w & 1);
  bf16x8 qf[2][4];
#pragma unroll
  for (int tl = 0; tl < 2; ++tl) {
    const int qi = qoff + 32 * tl + r, tr = qrow0 + qi;
    const bf16_t* qp = Q + (size_t)tr * 1024 + head * 64 + 8 * h;
    float x[4][8];
#pragma unroll
    for (int s = 0; s < 4; ++s) unpack8(*(const u32x4*)(qp + 16 * s), x[s]);
    if (!isctx) {
      const int t = n * 128 + qi; const int pr = t >> 6, pc = t & 63;
#pragma unroll
      for (int ax = 0; ax < 2; ++ax) { const int pos = ax ? pc : pr;
#pragma unroll
        for (int j = 0; j < 8; ++j) { const float cs = ropec[pos * 16 + 8 * h + j], sn = ropes[pos * 16 + 8 * h + j];
          const float x1 = x[2 * ax][j], x2 = x[2 * ax + 1][j]; x[2 * ax][j] = x1 * cs - x2 * sn; x[2 * ax + 1][j] = x1 * sn + x2 * cs; } }
    }
#pragma unroll
    for (int s = 0; s < 4; ++s) { u32x4 wv; wv.x = pk2(x[s][0] * QSCALE, x[s][1] * QSCALE); wv.y = pk2(x[s][2] * QSCALE, x[s][3] * QSCALE); wv.z = pk2(x[s][4] * QSCALE, x[s][5] * QSCALE); wv.w = pk2(x[s][6] * QSCALE, x[s][7] * QSCALE);
      qf[tl][s] = __builtin_bit_cast(bf16x8, wv); }
  }
  f32x16 oacc[2][2];
  float mrun[2], lrun[2];
#pragma unroll
  for (int tl = 0; tl < 2; ++tl) { mrun[tl] = -1e30f; lrun[tl] = 0.f;
#pragma unroll
    for (int dh = 0; dh < 2; ++dh)
#pragma unroll
      for (int i = 0; i < 16; ++i) oacc[tl][dh][i] = 0.f; }
  const int ntile = isctx ? 2 : 5;
  auto tile_valid = [&](int ti) { return isctx || !((ti == 1 && n == 0) || (ti == 2 && n == 63)); };
  auto tile_row0 = [&](int ti) { return isctx ? NTL + b * CTXL + ti * 128 : (ti == 0 ? b * SEQ + n * 128 : ti == 1 ? b * SEQ + (n - 1) * 128 : ti == 2 ? b * SEQ + (n + 1) * 128 : NTL + b * CTXL + (ti - 3) * 128); };
  const int kr = c.tid >> 2, pcx = c.tid & 3, c1 = (pcx & 1) + 4 * (pcx >> 1), kax = pcx >> 1;
  u32x4 pk1, pk2_, pv0, pv1;
  auto prefetch = [&](int ti) { const int krow0 = tile_row0(ti);
    const bf16_t* kp = Kg + (size_t)(krow0 + kr) * 256 + g * 64; pk1 = *(const u32x4*)(kp + 8 * c1); pk2_ = *(const u32x4*)(kp + 8 * c1 + 16);
    pv0 = *(const u32x4*)(Vt + (size_t)(g * 64 + (c.tid >> 4)) * NTOK + krow0 + 8 * (c.tid & 15));
    pv1 = *(const u32x4*)(Vt + (size_t)(g * 64 + 32 + (c.tid >> 4)) * NTOK + krow0 + 8 * (c.tid & 15)); };
  prefetch(0);
  for (int ti = 0; ti < ntile; ++ti) {
    if (!tile_valid(ti)) continue;
    const int krow0 = tile_row0(ti);
    const int mode = (!isctx && ti == 1) ? 1 : ((!isctx && ti == 2) ? 2 : 0);
    const bool rope = !isctx && ti < 3;
    __syncthreads();
    {
      float x1[8], x2[8]; unpack8(pk1, x1); unpack8(pk2_, x2);
      if (rope) { const int t = (krow0 + kr) & (SEQ - 1); const int pos = kax ? (t & 63) : (t >> 6); const int f0 = 8 * (pcx & 1);
#pragma unroll
        for (int j = 0; j < 8; ++j) { const float cs = ropec[pos * 16 + f0 + j], sn = ropes[pos * 16 + f0 + j]; const float a = x1[j], bb = x2[j]; x1[j] = a * cs - bb * sn; x2[j] = a * sn + bb * cs; } }
      u32x4 w1, w2; w1.x = pk2(x1[0], x1[1]); w1.y = pk2(x1[2], x1[3]); w1.z = pk2(x1[4], x1[5]); w1.w = pk2(x1[6], x1[7]);
      w2.x = pk2(x2[0], x2[1]); w2.y = pk2(x2[2], x2[3]); w2.z = pk2(x2[4], x2[5]); w2.w = pk2(x2[6], x2[7]);
      *(u32x4*)(Ks + kr * KS_LD + 8 * c1) = w1; *(u32x4*)(Ks + kr * KS_LD + 8 * c1 + 16) = w2;
      *(u32x4*)(Vs + (c.tid >> 4) * VS_LD + 8 * (c.tid & 15)) = pv0; *(u32x4*)(Vs + (32 + (c.tid >> 4)) * VS_LD + 8 * (c.tid & 15)) = pv1;
    }
    __syncthreads();
    { int tn = ti + 1; while (tn < ntile && !tile_valid(tn)) ++tn; if (tn < ntile) prefetch(tn); }
#pragma unroll 1
    for (int ks = 0; ks < 4; ++ks) {
      bf16x8 kf[4];
#pragma unroll
      for (int s = 0; s < 4; ++s) kf[s] = *(const bf16x8*)(Ks + (32 * ks + r) * KS_LD + 16 * s + 8 * h);
      bf16x8 vf[2][2];
#pragma unroll
      for (int dh = 0; dh < 2; ++dh)
#pragma unroll
        for (int s = 0; s < 2; ++s) { const bf16_t* vp = Vs + (32 * dh + r) * VS_LD + 32 * ks + 16 * s + 4 * h;
          const s16x4 lo = *(const s16x4*)vp, hi = *(const s16x4*)(vp + 8); vf[dh][s] = __builtin_shufflevector(lo, hi, 0, 1, 2, 3, 4, 5, 6, 7); }
#pragma unroll
      for (int tl = 0; tl < 2; ++tl) {
        { const int q0 = qoff + 32 * tl; if ((mode == 1 && 32 * ks + 31 < q0) || (mode == 2 && 32 * ks > q0 + 31)) continue; }
        f32x16 x;
#pragma unroll
        for (int i = 0; i < 16; ++i) x[i] = 0.f;
#pragma unroll
        for (int s = 0; s < 4; ++s) x = MFMA32(kf[s], qf[tl][s], x);
        const int qi = qoff + 32 * tl + r;
        if (mode) {
#pragma unroll
          for (int i = 0; i < 16; ++i) { const int kj = 32 * ks + (i & 3) + 8 * (i >> 2) + 4 * h; const bool ok = mode == 1 ? (kj >= qi) : (kj <= qi); x[i] = ok ? x[i] : -1e30f; }
        }
        float mx = x[0];
#pragma unroll
        for (int i = 1; i < 16; ++i) mx = fmaxf(mx, x[i]);
        mx = fmaxf(mx, __shfl_xor(mx, 32));
        const float mnew = fmaxf(mrun[tl], mx), alpha = __builtin_amdgcn_exp2f(mrun[tl] - mnew);
        float ps = 0.f;
#pragma unroll
        for (int i = 0; i < 16; ++i) { x[i] = __builtin_amdgcn_exp2f(x[i] - mnew); ps += x[i]; }
        ps += __shfl_xor(ps, 32);
        lrun[tl] = lrun[tl] * alpha + ps; mrun[tl] = mnew;
        if (__any(alpha != 1.0f)) {
#pragma unroll
          for (int dh = 0; dh < 2; ++dh)
#pragma unroll
            for (int i = 0; i < 16; ++i) oacc[tl][dh][i] *= alpha;
        }
#pragma unroll
        for (int s = 0; s < 2; ++s) { u32x4 pw; pw.x = pk2(x[8 * s], x[8 * s + 1]); pw.y = pk2(x[8 * s + 2], x[8 * s + 3]); pw.z = pk2(x[8 * s + 4], x[8 * s + 5]); pw.w = pk2(x[8 * s + 6], x[8 * s + 7]);
          const bf16x8 pf = __builtin_bit_cast(bf16x8, pw);
          oacc[tl][0] = MFMA32(vf[0][s], pf, oacc[tl][0]); oacc[tl][1] = MFMA32(vf[1][s], pf, oacc[tl][1]); }
      }
    }
  }
  const float sink = p->in[22][l * 16 + head] * 1.4426950408889634f;
#pragma unroll
  for (int tl = 0; tl < 2; ++tl) {
    const float lt = lrun[tl] + __builtin_amdgcn_exp2f(sink - mrun[tl]); const float inv = 1.0f / lt;
    const int tr = qrow0 + qoff + 32 * tl + r;
    bf16_t* op = O + (size_t)tr * 1024 + head * 64;
#pragma unroll
    for (int dh = 0; dh < 2; ++dh)
#pragma unroll
      for (int gq = 0; gq < 4; ++gq) { u32x2 wv; wv.x = pk2(oacc[tl][dh][4 * gq] * inv, oacc[tl][dh][4 * gq + 1] * inv); wv.y = pk2(oacc[tl][dh][4 * gq + 2] * inv, oacc[tl][dh][4 * gq + 3] * inv);
        *(u32x2*)(op + 32 * dh + 8 * gq + 4 * h) = wv; }
  }
  __syncthreads();
}

constexpr int SC_CH = 48;
constexpr int SC_STEP_F = 5 * 64 + 16;
constexpr int SC_BUF_F = SC_CH * SC_STEP_F;
constexpr int SC_NCHUNK = (CTXL + SEQ) / SC_CH;

constexpr int SC_NIT = SC_CH / 8;
struct ScanRegs { unsigned rk[SC_NIT][9]; unsigned ev[SC_NIT], av[SC_NIT]; };

DI int scan_row(int s, int dir, int b, int& pos, int& seqlen) {
  if (s < CTXL) { pos = dir ? CTXL - 1 - s : s; seqlen = CTXL; return NTL + b * CTXL + pos; }
  const int s2 = s - CTXL; pos = dir ? SEQ - 1 - s2 : s2; seqlen = SEQ; return b * SEQ + pos;
}

DI void phase_scan(const Ctx& c, PP p, int l) {
  float* bufs = (float*)c.lds;
  float* ybuf = bufs + 2 * SC_BUF_F;
  const int xcd = c.bid & 7, slot = c.bid >> 3;
  const int chain = xcd * 8 + (slot >> 2), part = slot & 3;
  const int dir = chain >> 5, b = (chain >> 4) & 1, hd = chain & 15;
  const bf16_t* RKV = (const bf16_t*)(p->ws + WS_RKV);
  const bf16_t* EE = (const bf16_t*)(p->ws + WS_LOUT + (size_t)dir * SZ16); const bf16_t* AS = (const bf16_t*)(p->ws + WS_LOUT + (size_t)(2 + dir) * SZ16);
  bf16_t* Y = (bf16_t*)(p->ws + (dir ? WS_YB2 : WS_H));
  const bool loader = c.wave >= 4;
  const int lt = c.tid - 256, lw = lt >> 6, half = (c.lane >> 5), cp = c.lane & 31;
  float mu0[3][2], mu1[3][2], kkw[2], kaw[2];
  if (loader) {
    const float* mu = p->in[10] + (size_t)l * 2 * 3072;
#pragma unroll
    for (int q = 0; q < 3; ++q)
#pragma unroll
      for (int e = 0; e < 2; ++e) { const int cc = q * 1024 + hd * 64 + 2 * cp + e; mu0[q][e] = mu[cc]; mu1[q][e] = mu[3072 + cc]; }
#pragma unroll
    for (int e = 0; e < 2; ++e) { kkw[e] = p->in[16][(size_t)l * 1024 + hd * 64 + 2 * cp + e]; kaw[e] = p->in[17][(size_t)l * 1024 + hd * 64 + 2 * cp + e]; }
  }
  ScanRegs R;
  auto issue = [&](int chunk) {
#pragma unroll
    for (int i = 0; i < SC_NIT; ++i) { const int s = chunk * SC_CH + 8 * i + 2 * lw + half; int pos, seqlen; const int row = scan_row(s, dir, b, pos, seqlen);
      const int rp = pos > 0 ? row - 1 : row, rn = pos + 1 < seqlen ? row + 1 : row;
#pragma unroll
      for (int q = 0; q < 3; ++q) { const int cc = q * 1024 + hd * 64 + 2 * cp;
        R.rk[i][q * 3 + 0] = *(const unsigned*)(RKV + (size_t)rp * 3072 + cc); R.rk[i][q * 3 + 1] = *(const unsigned*)(RKV + (size_t)row * 3072 + cc); R.rk[i][q * 3 + 2] = *(const unsigned*)(RKV + (size_t)rn * 3072 + cc); }
      R.ev[i] = *(const unsigned*)(EE + (size_t)row * 1024 + hd * 64 + 2 * cp); R.av[i] = *(const unsigned*)(AS + (size_t)row * 1024 + hd * 64 + 2 * cp); }
  };
  auto process = [&](int chunk, float* buf) {
#pragma unroll
    for (int i = 0; i < SC_NIT; ++i) { const int j = 8 * i + 2 * lw + half; const int s = chunk * SC_CH + j; int pos, seqlen; (void)scan_row(s, dir, b, pos, seqlen);
      const float mp = pos > 0 ? 1.f : 0.f, mn = pos + 1 < seqlen ? 1.f : 0.f;
      float x[3][2];
#pragma unroll
      for (int q = 0; q < 3; ++q) {
        x[q][0] = mp * mu0[q][0] * bflo(R.rk[i][q * 3]) + (1.0f - mu0[q][0] - mu1[q][0]) * bflo(R.rk[i][q * 3 + 1]) + mn * mu1[q][0] * bflo(R.rk[i][q * 3 + 2]);
        x[q][1] = mp * mu0[q][1] * bfhi(R.rk[i][q * 3]) + (1.0f - mu0[q][1] - mu1[q][1]) * bfhi(R.rk[i][q * 3 + 1]) + mn * mu1[q][1] * bfhi(R.rk[i][q * 3 + 2]); }
      const float k0 = x[1][0] * kkw[0], k1 = x[1][1] * kkw[1];
      float ss = k0 * k0 + k1 * k1;
      ss = ar16(ss); ss += __shfl_xor(ss, 16);
      const float nr = rsqrtf(ss + 1e-12f);
      const float kn0 = k0 * nr, kn1 = k1 * nr;
      const float e0 = bflo(R.ev[i]), e1 = bfhi(R.ev[i]), a0 = bflo(R.av[i]), a1 = bfhi(R.av[i]);
      float* st = buf + j * SC_STEP_F;
      *(f32x2*)(st + 0 * 64 + 2 * cp) = (f32x2){-kn0, -kn1};
      *(f32x2*)(st + 1 * 64 + 2 * cp) = (f32x2){__expf(-e0), __expf(-e1)};
      *(f32x2*)(st + 2 * 64 + 2 * cp) = (f32x2){kn0 * a0, kn1 * a1};
      *(f32x2*)(st + 3 * 64 + 2 * cp) = (f32x2){x[1][0] * (1.0f + (a0 - 1.0f) * kaw[0]), x[1][1] * (1.0f + (a1 - 1.0f) * kaw[1])};
      *(f32x2*)(st + 4 * 64 + 2 * cp) = (f32x2){x[0][0], x[0][1]};
      if ((cp >> 3) == part) *(f32x2*)(st + 5 * 64 + 2 * (cp & 7)) = (f32x2){x[2][0], x[2][1]};
    }
  };
  auto flush = [&](int chunk, const float* yb) {
    for (int j = lt >> 3; j < SC_CH; j += 32) { const int pr = lt & 7; const int s = chunk * SC_CH + j; int pos, seqlen; const int row = scan_row(s, dir, b, pos, seqlen);
      *(unsigned*)(Y + (size_t)row * 1024 + hd * 64 + 16 * part + 2 * pr) = pk2(yb[j * 16 + 2 * pr], yb[j * 16 + 2 * pr + 1]); }
  };
  __syncthreads();
  if (loader) { issue(0); process(0, bufs); issue(1); }
  __syncthreads();
  f32x4 S = {0.f, 0.f, 0.f, 0.f};
  const int rr = c.lane >> 4, ll = c.lane & 15;
  for (int ch = 0; ch < SC_NCHUNK; ++ch) {
    float* buf = bufs + (ch & 1) * SC_BUF_F;
    if (!loader) {
      float* yb = ybuf + (ch & 1) * (SC_CH * 16);
      const float* st = buf + 4 * ll; const float* vp = buf + 5 * 64 + 4 * c.wave + rr;
      f32x4 na = *(const f32x4*)(st), nw = *(const f32x4*)(st + 64), nb = *(const f32x4*)(st + 128), nk = *(const f32x4*)(st + 192), nr = *(const f32x4*)(st + 256); float nv = vp[0];
#pragma unroll
      for (int jb = 0; jb < SC_CH; jb += 16) {
        float ysel = 0.f;
#pragma unroll
        for (int jj = 0; jj < 16; ++jj) {
          const int j = jb + jj;
          const f32x4 a = na, wv = nw, bv = nb, kd = nk, rv = nr; const float vv = nv;
          if (j + 1 < SC_CH) { const float* sn = st + (j + 1) * SC_STEP_F;
            na = *(const f32x4*)(sn); nw = *(const f32x4*)(sn + 64); nb = *(const f32x4*)(sn + 128); nk = *(const f32x4*)(sn + 192); nr = *(const f32x4*)(sn + 256); nv = vp[(j + 1) * SC_STEP_F]; }
          f32x2 t1 = S.lo * a.lo; t1 = S.hi * a.hi + t1; float sa = t1.x + t1.y;
          sa = ar16(sa);
          S = S * wv + (bv * sa + kd * vv);
          f32x2 t2 = S.lo * rv.lo; t2 = S.hi * rv.hi + t2; float y = t2.x + t2.y;
          y = ar16(y);
          ysel = (ll == jj) ? y : ysel;
        }
        yb[(jb + ll) * 16 + 4 * c.wave + rr] = ysel;
      }
    } else {
      if (ch + 1 < SC_NCHUNK) process(ch + 1, bufs + ((ch + 1) & 1) * SC_BUF_F);
      if (ch + 2 < SC_NCHUNK) issue(ch + 2);
      if (ch > 0) flush(ch - 1, ybuf + ((ch - 1) & 1) * (SC_CH * 16));
    }
    __syncthreads();
  }
  if (loader) flush(SC_NCHUNK - 1, ybuf + ((SC_NCHUNK - 1) & 1) * (SC_CH * 16));
  __syncthreads();
}

#if !defined(NO_GEMM) && (!defined(GEMM_ONLY) || GEMM_ONLY == 0)
#define GEMMCALL0(a,b,c,d) pg8::gemm_phase(a,b,c,d)
#else
#define GEMMCALL0(a,b,c,d) (void)0
#endif
#if !defined(NO_GEMM) && (!defined(GEMM_ONLY) || GEMM_ONLY == 1)
#define GEMMCALL1(a,b,c,d) pg8::gemm_phase(a,b,c,d)
#else
#define GEMMCALL1(a,b,c,d) (void)0
#endif
#if !defined(NO_GEMM) && (!defined(GEMM_ONLY) || GEMM_ONLY == 2)
#define GEMMCALL2(a,b,c,d) pg8::gemm_phase(a,b,c,d)
#else
#define GEMMCALL2(a,b,c,d) (void)0
#endif
#if !defined(NO_GEMM) && (!defined(GEMM_ONLY) || GEMM_ONLY == 3)
#define GEMMCALL3(a,b,c,d) pg8::gemm_phase(a,b,c,d)
#else
#define GEMMCALL3(a,b,c,d) (void)0
#endif
#if !defined(NO_GEMM) && (!defined(GEMM_ONLY) || GEMM_ONLY == 4)
#define GEMMCALL4(a,b,c,d) pg8::gemm_phase(a,b,c,d)
#else
#define GEMMCALL4(a,b,c,d) (void)0
#endif
#if !defined(NO_GEMM) && (!defined(GEMM_ONLY) || GEMM_ONLY == 5)
#define GEMMCALL5(a,b,c,d) pg8::gemm_phase(a,b,c,d)
#else
#define GEMMCALL5(a,b,c,d) (void)0
#endif
#if !defined(NO_GEMM) && (!defined(GEMM_ONLY) || GEMM_ONLY == 6)
#define GEMMCALL6(a,b,c,d) pg8::gemm_phase(a,b,c,d)
#else
#define GEMMCALL6(a,b,c,d) (void)0
#endif
#if !defined(NO_GEMM) && (!defined(GEMM_ONLY) || GEMM_ONLY == 7)
#define GEMMCALL7(a,b,c,d) pg8::gemm_phase(a,b,c,d)
#else
#define GEMMCALL7(a,b,c,d) (void)0
#endif
#if !defined(NO_GEMM) && (!defined(GEMM_ONLY) || GEMM_ONLY == 8)
#define GEMMCALL8(a,b,c,d) pg8::gemm_phase(a,b,c,d)
#else
#define GEMMCALL8(a,b,c,d) (void)0
#endif
#define GSYNC() do { unsigned char* w_ = p0->ws; asm volatile("" : "+s"(w_)); xcd_barrier((unsigned*)(w_ + WS_BAR), (volatile LAS unsigned*)(ldsl + LDS_BAR_OFF)); } while (0)
#ifdef PROBE_ID
#define TSTART(id) do { if (((1u << (id)) & (unsigned)(PROBE_ID)) && blockIdx.x == 0 && threadIdx.x == 0) *(volatile LAS unsigned long long*)(ldsl + LDS_BAR_OFF + 16) -= __builtin_amdgcn_s_memrealtime(); } while (0)
#define TSTOP(id) do { if (((1u << (id)) & (unsigned)(PROBE_ID)) && blockIdx.x == 0 && threadIdx.x == 0) *(volatile LAS unsigned long long*)(ldsl + LDS_BAR_OFF + 16) += __builtin_amdgcn_s_memrealtime(); } while (0)
#else
#define TSTART(id) (void)0
#define TSTOP(id) (void)0
#endif
#define FRESH() do { int t_ = threadIdx.x; asm volatile("" : "+v"(t_)); c.tid = t_; c.lane = t_ & 63; c.wave = __builtin_amdgcn_readfirstlane(t_ >> 6); int b_ = blockIdx.x; asm volatile("" : "+s"(b_)); c.bid = b_; p = p0; asm volatile("" : "+s"(p)); ws = p->ws; } while (0)
#define mod_all ((float*)(ws + WS_MOD))
#define xc ((float*)(ws + WS_XC))
#define H ((bf16_t*)(ws + WS_H))
template <int l>
DI void layer_body(Ctx& c, const PP p0, cg::grid_group& grid, LAS unsigned char* ldsl, unsigned long long& tacc) {
  PP p = p0; unsigned char* ws = p->ws;
  constexpr int MROWS = (l == DEPTH - 1) ? NTL : NTOK;
  TSTART(1);
    const float* xLin = l == 0 ? p->in[0] : p->out; const float* xCin = xc;
    const float* mod = mod_all + (size_t)l * 3 * 6144;
#ifndef NO_SMALL
    TSTART(12); FRESH(); if (l > 0) phase_convert(c, p, l); TSTOP(12);
    FRESH(); phase_norm(c, p, xLin, xc, p->in[6] + (size_t)l * 1024, mod, 0, l == 0 ? 0 : 11);
#endif
    GSYNC();
  TSTOP(1);
  TSTART(2);
    { pg8::Gemm g{H, (const bf16_t*)(ws + WS_WIN), NTOK, 11008, 1024, 1024, 1024, (const bf16_t*)(ws + WS_WV), H, nullptr, nullptr}; FRESH(); pg8::StaticOrder S; S.init(NTOK, 11008, c.nb, c.bid, NTOK / 256); pg8::EpiIn E{ws}; GEMMCALL0(ldsl, g, S, E); }
    GSYNC();
  TSTOP(2);
  TSTART(3);
    { pg8::Gemm g{(const bf16_t*)(ws + WS_LACT), (const bf16_t*)(ws + WS_WLORA), NTOK, 5120, 384, 512, 384, nullptr, nullptr, nullptr, nullptr}; FRESH(); pg8::LoraOrder S; S.S.init(NTOK, 5120, c.nb, c.bid);
      pg8::EpiLora E{ws, p->in[11] + (size_t)l * 2048, p->in[13] + (size_t)l * 2048}; GEMMCALL2(ldsl, g, S, E); }
    GSYNC();
  TSTOP(3);
  TSTART(4);
    { const int nunits = (l == DEPTH - 1) ? 512 : 528;
#ifndef NO_ATTN
      TSTART(13); FRESH(); for (int u = c.bid; u < nunits; u += c.nb) attn_unit(c, p, l, u); TSTOP(13);
#endif
#ifndef NO_CONVA
      TSTART(14); FRESH(); phase_conv_a(c, p, l); TSTOP(14);
#endif
#ifndef NO_SCAN
      FRESH(); phase_scan(c, p, l);
#endif
    }
    GSYNC();
  TSTOP(4);
  TSTART(5);
#ifndef NO_FIN
    FRESH(); phase_rwkv_fin(c, p, l);
#endif
    GSYNC();
  TSTOP(5);
  TSTART(6);
    { pg8::Gemm g{(const bf16_t*)(ws + WS_AB), (const bf16_t*)(ws + WS_WA), NTOK, 1024, 1024, 1024, 1024,
                  (const bf16_t*)(ws + WS_H), (const bf16_t*)(ws + WS_WA + AL((size_t)1024 * 1024 * 2)), (const bf16_t*)(ws + WS_Q), (const bf16_t*)(ws + WS_WA + 2 * AL((size_t)1024 * 1024 * 2))};
      FRESH(); pg8::MergeOrder S; S.S.init(NTL, 1024, c.nb, c.bid); S.nctx = (l == DEPTH - 1) ? 0 : 24; pg8::EpiMergeChain E{ws}; GEMMCALL3(ldsl, g, S, E); }
    if (l < DEPTH - 1) { GSYNC(); FRESH(); phase_mctx(c, p); }
    GSYNC();
  TSTOP(6);
  TSTART(7);
    { const bf16_t* A_ = (const bf16_t*)(ws + WS_YB2); const bf16_t* B_ = (const bf16_t*)(ws + WS_WA + 3 * AL((size_t)1024 * 1024 * 2));
      pg8::Gemm g{A_, B_, NTOK, 1024, 1024, 1024, 1024, A_, B_, nullptr, nullptr}; FRESH(); pg8::ResOrder S; S.S.init(NTL, 1024, c.nb, c.bid); S.ks = 4; S.nktq = 4; S.nsplit = (l == DEPTH - 1) ? 0 : 32;
      pg8::EpiRes E{xLin, xCin, p->out, xc, mod + 2 * 1024, (float*)(ws + WS_CPART), 4}; GEMMCALL6(ldsl, g, S, E); }
    GSYNC();
  TSTOP(7);
  TSTART(8);
    FRESH(); phase_norm(c, p, p->out, xc, p->in[25] + (size_t)l * 1024, mod, 3, l == DEPTH - 1 ? 0 : 4);
    GSYNC();
  TSTOP(8);
  TSTART(9);
    { pg8::Gemm g{H, (const bf16_t*)(ws + WS_WUP), NTOK, 5632, 1024, 1024, 1024, nullptr, nullptr, nullptr, nullptr}; FRESH(); pg8::StaticOrder S; S.init(MROWS, 5632, c.nb, c.bid); pg8::EpiPlain E{(bf16_t*)(ws + WS_U), 5632}; GEMMCALL7(ldsl, g, S, E); }
    GSYNC();
  TSTOP(9);
  TSTART(10);
#ifndef NO_FFNACT
    FRESH(); phase_ffn_act(c, p, l);
#endif
    GSYNC();
  TSTOP(10);
  TSTART(11);
    { const bf16_t* A_ = (const bf16_t*)(ws + WS_GATES); const bf16_t* B_ = (const bf16_t*)(ws + WS_WDN);
      pg8::Gemm g{A_, B_, NTOK, 1024, 2816, 2816, 2816, A_, B_, nullptr, nullptr}; FRESH(); pg8::ResOrder S; S.S.init(NTL, 1024, c.nb, c.bid); S.ks = 11; S.nktq = 4; S.nsplit = (l == DEPTH - 1) ? 0 : 88;
      pg8::EpiRes E{p->out, xc, p->out, xc, mod + 5 * 1024, (float*)(ws + WS_CPART), 4}; GEMMCALL8(ldsl, g, S, E); }
    GSYNC();
  TSTOP(11);
  }

__global__ void __launch_bounds__(NTHR, 2) mega(Params pv) {
  extern __shared__ __attribute__((aligned(16))) unsigned char lds[];
  cg::grid_group grid = cg::this_grid();
  const PP p0 = (PP)__builtin_amdgcn_kernarg_segment_ptr(); PP p = p0;
  Ctx c; c.tid = threadIdx.x; c.lane = c.tid & 63; c.wave = __builtin_amdgcn_readfirstlane(c.tid >> 6); c.bid = blockIdx.x; c.nb = gridDim.x; c.lds = lds;
  LAS unsigned char* ldsl = (LAS unsigned char*)lds;
  unsigned char* ws = p->ws;
  unsigned long long tacc = 0ull;
  if (c.tid < 8) ((volatile LAS unsigned*)(ldsl + LDS_BAR_OFF))[c.tid] = 0u;
  __syncthreads();
  if (c.tid == 0) (void)xb_add(&((unsigned*)(ws + WS_BAR))[XB_XCNT(xb_xcc_id())], 1u);
  TSTART(15);
  FRESH(); phase_mods(c, p);
  TSTOP(15); TSTART(16);
  FRESH(); phase_convert(c, p, 0);
  grid.sync();
  TSTOP(16);
  layer_body<0>(c, p0, grid, ldsl, tacc);
  layer_body<1>(c, p0, grid, ldsl, tacc);
  layer_body<2>(c, p0, grid, ldsl, tacc);
  layer_body<3>(c, p0, grid, ldsl, tacc);
#ifdef PROBE_ID
  if (blockIdx.x == 0 && threadIdx.x == 0) { *(volatile unsigned long long*)(p0->ws + WS_BAR + 15360) = *(volatile LAS unsigned long long*)(ldsl + LDS_BAR_OFF + 16); }
  GSYNC();
  FRESH(); phase_final(c, p, sqrtf((float)(*(volatile unsigned long long*)(p0->ws + WS_BAR + 15360)) * 2e-10f));
#else
  FRESH(); phase_final(c, p, 0.f);
#endif
}

extern "C" void kernel_launch(void* const* d_in, const int* in_sizes, int n_in, void* d_out, int out_size, void* d_ws, size_t ws_size, hipStream_t stream) {
  static int grid = 0;
  if (grid == 0) {
    int dev = 0, cus = 0, per_cu = 0;
    (void)hipGetDevice(&dev); (void)hipDeviceGetAttribute(&cus, hipDeviceAttributeMultiprocessorCount, dev);
    (void)hipFuncSetAttribute((const void*)mega, hipFuncAttributeMaxDynamicSharedMemorySize, LDS_BYTES);
    (void)hipOccupancyMaxActiveBlocksPerMultiprocessor(&per_cu, (const void*)mega, NTHR, LDS_BYTES);
    grid = cus < 256 ? cus : 256;
    if (n_in != 30 || ws_size < WS_END || per_cu < 1) { fprintf(stderr, "kernel_launch: n_in %d ws %zu need %zu per_cu %d\n", n_in, ws_size, (size_t)WS_END, per_cu); if (n_in != 30 || ws_size < WS_END) grid = -1; }
  }
  if (grid < 0) return;
  Params p{};
  for (int i = 0; i < 30; ++i) p.in[i] = (const float*)d_in[i];
  p.out = (float*)d_out; p.ws = (unsigned char*)d_ws;
  (void)hipMemsetAsync((unsigned char*)d_ws + WS_BAR, 0, 32768, stream);
  void* args[] = {&p};
  hipError_t e = hipLaunchCooperativeKernel((const void*)mega, dim3(grid), dim3(NTHR), args, LDS_BYTES, stream);
  if (e != hipSuccess) fprintf(stderr, "cooperative launch failed: %s (grid %d)\n", hipGetErrorString(e), grid);
}
```

```cpp
#include <hip/hip_runtime.h>
#include <hip/hip_cooperative_groups.h>
#include <cstdio>
namespace cg = cooperative_groups;

#define LAS __attribute__((address_space(3)))
#define DI __device__ __forceinline__
typedef unsigned short bf16_t;
typedef short bf16x8 __attribute__((ext_vector_type(8)));
typedef short s16x4 __attribute__((ext_vector_type(4)));
typedef float f32x2 __attribute__((ext_vector_type(2)));
typedef float f32x4 __attribute__((ext_vector_type(4)));
typedef float f32x16 __attribute__((ext_vector_type(16)));
typedef unsigned u32x2 __attribute__((ext_vector_type(2)));
typedef unsigned u32x4 __attribute__((ext_vector_type(4)));
typedef __bf16 bf16x2_t __attribute__((ext_vector_type(2)));

constexpr int DM = 1024, NB = 2, SEQ = 8192, DEPTH = 4, CTXL = 256;
constexpr int NTL = NB * SEQ;
constexpr int NTC = NB * CTXL;
constexpr int NTOK = NTL + NTC;
constexpr int NIN = 11136, DFF = 2816;
constexpr int NTHR = 512;
constexpr int LDS_BAR_OFF = 135168;
constexpr int LDS_BYTES = LDS_BAR_OFF + 64;

constexpr size_t AL(size_t x) { return (x + 255) & ~(size_t)255; }
constexpr size_t SZ16 = (size_t)NTOK * 1024 * 2;
constexpr size_t WS_BAR   = 0;
constexpr size_t WS_MOD   = 32768;
constexpr size_t WS_ROPE  = WS_MOD + AL((size_t)DEPTH * 3 * 6144 * 4);
constexpr size_t WS_XC    = WS_ROPE + AL(128 * 16 * 2 * 4);
constexpr size_t WS_WIN   = WS_XC + AL((size_t)NTC * 1024 * 4);
constexpr size_t WS_WV    = WS_WIN + AL((size_t)11008 * 1024 * 2);
constexpr size_t WS_WLORA = WS_WV + AL((size_t)256 * 1024 * 2);
constexpr size_t WS_WA    = WS_WLORA + AL((size_t)5120 * 384 * 2);
constexpr size_t WS_WUP   = WS_WA + 4 * AL((size_t)1024 * 1024 * 2);
constexpr size_t WS_WDN   = WS_WUP + AL((size_t)5632 * 1024 * 2);
constexpr size_t WS_H     = WS_WDN + AL((size_t)1024 * 2816 * 2);
constexpr size_t WS_AB    = WS_H + SZ16;
constexpr size_t WS_AC    = WS_AB + SZ16;
constexpr size_t WS_AX    = WS_AC + SZ16;
constexpr size_t WS_RKV   = WS_AX + SZ16;
constexpr size_t WS_LACT  = WS_RKV + 3 * SZ16;
constexpr size_t WS_Q     = WS_LACT + SZ16 / 2;
constexpr size_t WS_K     = WS_Q + SZ16;
constexpr size_t WS_VT    = WS_K + SZ16 / 4;
constexpr size_t WS_GATES = WS_VT + SZ16 / 4;
constexpr size_t WS_LOUT  = WS_GATES + 3 * SZ16;
constexpr size_t WS_YB2   = WS_LOUT + 5 * SZ16;
constexpr size_t WS_CPART = WS_YB2 + SZ16;
constexpr size_t WS_END   = WS_CPART + (size_t)11 * NTC * 1024 * 4;
constexpr size_t WS_U     = WS_AB;
static_assert((size_t)NTOK * 5632 * 2 <= 6 * SZ16, "u alias");
static_assert(WS_END <= (size_t)729 * 1000 * 1000, "workspace");

struct Params {
  const float* in[30];
  float* out;
  unsigned char* ws;
};

typedef const __attribute__((address_space(4))) Params* PP;
DI float bf2f(unsigned v) { return __uint_as_float(v << 16); }
DI float bflo(unsigned v) { return __uint_as_float(v << 16); }
DI float bfhi(unsigned v) { return __uint_as_float(v & 0xffff0000u); }
DI unsigned pk2(float a, float b) { f32x2 v = {a, b}; bf16x2_t r = __builtin_convertvector(v, bf16x2_t); return __builtin_bit_cast(unsigned, r); }
DI void unpack8(const u32x4 w, float (&f)[8]) { f[0] = bflo(w.x); f[1] = bfhi(w.x); f[2] = bflo(w.y); f[3] = bfhi(w.y); f[4] = bflo(w.z); f[5] = bfhi(w.z); f[6] = bflo(w.w); f[7] = bfhi(w.w); }
DI float sigmoidf_(float x) { return __builtin_amdgcn_rcpf(1.0f + __builtin_amdgcn_exp2f(-1.4426950408889634f * x)); }
DI float wave_sum(float v) {
#pragma unroll
  for (int o = 32; o >= 1; o >>= 1) v += __shfl_xor(v, o);
  return v;
}
DI float ar16(float x) {
  x += __builtin_bit_cast(float, __builtin_amdgcn_update_dpp(0, __builtin_bit_cast(int, x), 0x128, 0xf, 0xf, false));
  x += __builtin_bit_cast(float, __builtin_amdgcn_update_dpp(0, __builtin_bit_cast(int, x), 0x124, 0xf, 0xf, false));
  x += __builtin_bit_cast(float, __builtin_amdgcn_update_dpp(0, __builtin_bit_cast(int, x), 0x122, 0xf, 0xf, false));
  x += __builtin_bit_cast(float, __builtin_amdgcn_update_dpp(0, __builtin_bit_cast(int, x), 0x121, 0xf, 0xf, false));
  return x;
}

#define XB_TMO      128
#define XB_XCNT(j)  (256  + 64 * (j))
#define XB_XSUB(j)  (1280 + 64 * (j))
#define XB_XGEN(j)  (2304 + 64 * (j))
#define XB_TOP      3328
#define XB_TOPGEN   3392
#define XCD_BAR_WORDS 3456
#define XB_SPIN_CAP (1u << 22)
DI unsigned xb_ld(unsigned* p)              { return __hip_atomic_load(p, __ATOMIC_RELAXED, __HIP_MEMORY_SCOPE_AGENT); }
DI unsigned xb_add(unsigned* p, unsigned v) { return __hip_atomic_fetch_add(p, v, __ATOMIC_RELAXED, __HIP_MEMORY_SCOPE_AGENT); }
DI unsigned xb_xcc_id() { return (unsigned)__builtin_amdgcn_s_getreg((3 << 11) | 20) & 0xFu; }
#define XB_SPIN(cond, bar) do { unsigned _sp = 0; while (cond) { __builtin_amdgcn_s_sleep(1); \
    if ((++_sp & 255u) == 0u) { if (xb_ld(&(bar)[XB_TMO])) break; if (_sp > XB_SPIN_CAP) { atomicAdd(&(bar)[XB_TMO], 1u); break; } } } } while (0)
DI void xcd_barrier_complete(unsigned* bar, unsigned x, unsigned& nloc, unsigned& nx) {
  const unsigned G = gridDim.x;
  unsigned sum, cnt, mine, sp = 0u;
  for (;;) {
    sum = 0u; cnt = 0u; mine = 0u;
#pragma unroll
    for (unsigned j = 0; j < 16; ++j) { const unsigned c = xb_ld(&bar[XB_XCNT(j)]); sum += c; cnt += (c > 0u) ? 1u : 0u; mine = (j == x) ? c : mine; }
    if (sum == G) break;
    __builtin_amdgcn_s_sleep(1);
    if ((++sp & 255u) == 0u) { if (xb_ld(&bar[XB_TMO])) break; if (sp > XB_SPIN_CAP) { atomicAdd(&bar[XB_TMO], 1u); break; } }
  }
  nloc = mine > 0u ? mine : 1u; nx = cnt > 0u ? cnt : 1u;
}
DI void xcd_barrier(unsigned* bar, volatile LAS unsigned* st) {
  asm volatile("s_waitcnt vmcnt(0)" ::: "memory");
  __syncthreads();
  if (threadIdx.x == 0) {
    const unsigned x = xb_xcc_id();
    __builtin_amdgcn_s_waitcnt(0);
    unsigned nloc = st[0], nx = st[1];
    if (nloc == 0u) { xcd_barrier_complete(bar, x, nloc, nx); st[0] = nloc; st[1] = nx; }
    const unsigned old = xb_add(&bar[XB_XSUB(x)], 1u);
    const unsigned gen = old / nloc;
    if (old + 1u == (gen + 1u) * nloc) {
      __builtin_amdgcn_fence(__ATOMIC_RELEASE, "agent");
      asm volatile("s_waitcnt vmcnt(0)" ::: "memory");
      const unsigned og = xb_add(&bar[XB_TOP], 1u);
      const unsigned tg = og / nx;
      if (og + 1u == (tg + 1u) * nx) xb_add(&bar[XB_TOPGEN], 1u);
      else XB_SPIN(xb_ld(&bar[XB_TOPGEN]) == tg, bar);
      __builtin_amdgcn_fence(__ATOMIC_ACQUIRE, "agent");
      xb_add(&bar[XB_XGEN(x)], 1u);
      asm volatile("s_waitcnt vmcnt(0)" ::: "memory");
    } else {
      XB_SPIN(xb_ld(&bar[XB_XGEN(x)]) == gen, bar);
      __builtin_amdgcn_fence(__ATOMIC_ACQUIRE, "agent");
      asm volatile("s_waitcnt vmcnt(0)" ::: "memory");
    }
  }
  __syncthreads();
}
namespace pg8 {
constexpr int BM = 256, BK = 64, HALF = 128, HTB = HALF * BK * 2, NXCD = 8, WGM = 8;
DI int lds_byte(int r, int c) { const int st = (r >> 4) * 2 + (c >> 5), rr = r & 15, cc = c & 31, ob = rr * 64 + cc * 2; return st * 1024 + (ob ^ (((ob >> 9) & 1) << 5)); }
DI void stage_rc(int b, int& R, int& C) { const int st = b / 1024, sb = b % 1024, swz = sb ^ (((sb >> 9) & 1) << 5); R = (st >> 1) * 16 + swz / 64; C = (st & 1) * 32 + (swz % 64) / 2; }
DI int perm32(int rho) { const int n = rho >> 4, i = rho & 15; return 8 * (i >> 2) + 4 * n + (i & 3); }
struct Unit { int pm, pn, which, kt0, nkt; };
struct Gemm { const bf16_t* A; const bf16_t* Bt; int M, N, K, lda, ldb; const bf16_t* A2; const bf16_t* Bt2; const bf16_t* A3; const bf16_t* Bt3; };
struct StaticOrder {
  int nM, nN, nwg, G, c, nwg2;
  DI void init(int M, int N, int G_, int c_, int n2 = 0) { nM = M / BM; nN = N / BM; nwg = nM * nN; G = G_; c = c_; nwg2 = n2; }
  DI bool next(int i, Unit& u) const {
    const long L = (long)i * G + c; u.which = 0; u.kt0 = 0; u.nkt = 0;
    if (L >= nwg) { if (L >= nwg + nwg2) return false; u.which = 1; u.pm = 0; u.pn = (int)L - nwg; return true; }
    int wgid = (int)L; { const int q = nwg / NXCD, r = nwg % NXCD, xcd = wgid % NXCD, off = wgid / NXCD; wgid = (xcd < r ? xcd * (q + 1) : r * (q + 1) + (xcd - r) * q) + off; }
    const int nig = WGM * nN, gid = wgid / nig, fm = gid * WGM, gsz = (nM - fm) < WGM ? (nM - fm) : WGM;
    u.pm = fm + ((wgid % nig) % gsz); u.pn = (wgid % nig) / gsz; return true;
  }
};

template <class Epi, class Sched>
DI void gemm_phase(LAS unsigned char* lds, const Gemm g, const Sched& S, const Epi& E) {
  int tid = threadIdx.x; asm volatile("" : "+v"(tid));
  const int wid = __builtin_amdgcn_readfirstlane(tid >> 6), lane = tid & 63, wr = wid >> 2, wc = wid & 3, fr = lane & 15, fq = lane >> 4;
  const int K = g.K, nt = K / BK;
  unsigned voffA[2], voffB[2];
#pragma unroll
  for (int i = 0; i < 2; ++i) { int R, C; stage_rc(tid * 16 + i * 8192, R, C); const int Rb = Epi::PERM ? ((R & ~31) + perm32(R & 31)) : R;
    voffA[i] = (unsigned)(R * g.lda + C) * 2u; voffB[i] = (unsigned)(Rb * g.ldb + C) * 2u; }
  const size_t kstep = (size_t)(BK * 2);
  const size_t hstepA = (size_t)HALF * g.lda * 2, hstepB = (size_t)HALF * g.ldb * 2;
  const size_t tstepA = 2 * hstepA, tstepB = 2 * hstepB;
  const unsigned ldsw = (unsigned)wid * 1024u;
#define PG8_SA(b, h) (((b) * 2 + (h)) * HTB)
#define PG8_SB(b, h) ((4 + (b) * 2 + (h)) * HTB)
#define PG8_STAGE(bufoff, gbase, voff) do { _Pragma("unroll") for (int _i = 0; _i < 2; ++_i) \
    __builtin_amdgcn_global_load_lds((const unsigned*)((const char*)(gbase) + (voff)[_i]), (LAS unsigned*)(lds + (bufoff) + ldsw + _i * 8192), 16, 0, 0); } while (0)
#define PG8_LDA(dst, b, h) do { _Pragma("unroll") for (int m = 0; m < 4; ++m) _Pragma("unroll") for (int k = 0; k < 2; ++k) dst[m][k] = *(const LAS bf16x8*)(lds + PG8_SA(b, h) + aoff + m * 2048 + k * 1024); } while (0)
#define PG8_LDB(dst, b, h) do { _Pragma("unroll") for (int n = 0; n < 2; ++n) _Pragma("unroll") for (int k = 0; k < 2; ++k) dst[n][k] = *(const LAS bf16x8*)(lds + PG8_SB(b, h) + boff + n * 2048 + k * 1024); } while (0)
#define PG8_MMA(ai, bj, At, Bt) do { __builtin_amdgcn_s_setprio(1); _Pragma("unroll") for (int m = 0; m < 4; ++m) _Pragma("unroll") for (int n = 0; n < 2; ++n) _Pragma("unroll") for (int k = 0; k < 2; ++k) \
    acc[ai][bj][m][n] = __builtin_amdgcn_mfma_f32_16x16x32_bf16(Bt[n][k], At[m][k], acc[ai][bj][m][n], 0, 0, 0); __builtin_amdgcn_s_setprio(0); } while (0)
#define PG8_WAIT_V(n) asm volatile("s_waitcnt vmcnt(" #n ")" ::: "memory")
#define PG8_WAIT_L(n) asm volatile("s_waitcnt lgkmcnt(" #n ")" ::: "memory")
#define PG8_BAR __builtin_amdgcn_s_barrier()
#define PG8_SCHED __builtin_amdgcn_sched_barrier(0)
  Unit cur, nxt; int ui = 0;
  if (!S.next(0, cur)) return;
  f32x4 acc[2][2][4][2];
#pragma unroll
  for (int a = 0; a < 2; ++a)
#pragma unroll
    for (int b = 0; b < 2; ++b)
#pragma unroll
      for (int m = 0; m < 4; ++m)
#pragma unroll
        for (int n = 0; n < 2; ++n) acc[a][b][m][n] = (f32x4){0.f, 0.f, 0.f, 0.f};
  bf16x8 At[4][2], B0[2][2], B1[2][2];
  const char* cA = (const char*)(cur.which == 0 ? g.A : (cur.which == 1 ? g.A2 : g.A3)) + (size_t)cur.pm * tstepA + (size_t)cur.kt0 * kstep; const char* cB = (const char*)(cur.which == 0 ? g.Bt : (cur.which == 1 ? g.Bt2 : g.Bt3)) + (size_t)cur.pn * tstepB + (size_t)cur.kt0 * kstep;
  PG8_STAGE(PG8_SB(0, 0), cB, voffB); PG8_STAGE(PG8_SA(0, 0), cA, voffA); PG8_STAGE(PG8_SB(0, 1), cB + hstepB, voffB); PG8_STAGE(PG8_SA(0, 1), cA + hstepA, voffA);
  if (wr == 1) PG8_BAR;
  PG8_WAIT_V(4); PG8_BAR;
  PG8_STAGE(PG8_SB(1, 0), cB + kstep, voffB); PG8_STAGE(PG8_SA(1, 0), cA + kstep, voffA); PG8_STAGE(PG8_SB(1, 1), cB + hstepB + kstep, voffB);
  PG8_WAIT_V(6); PG8_BAR;
  for (;;) {
    int t3 = threadIdx.x; asm volatile("" : "+v"(t3));
    const int aoff = lds_byte(wr * 64 + (t3 & 15), ((t3 & 63) >> 4) * 8), boff = lds_byte(wc * 32 + (t3 & 15), ((t3 & 63) >> 4) * 8);
    const bool has_next = S.next(ui + 1, nxt);
    const char* nA = has_next ? (const char*)(nxt.which == 0 ? g.A : (nxt.which == 1 ? g.A2 : g.A3)) + (size_t)nxt.pm * tstepA + (size_t)nxt.kt0 * kstep : cA; const char* nB = has_next ? (const char*)(nxt.which == 0 ? g.Bt : (nxt.which == 1 ? g.Bt2 : g.Bt3)) + (size_t)nxt.pn * tstepB + (size_t)nxt.kt0 * kstep : cB;
    const int ntu = cur.nkt > 0 ? cur.nkt : nt;
    for (int t = 0; t < ntu; t += 2) {
      const bool last = (t == ntu - 2);
      const char* a1 = cA + (size_t)(t + 1) * kstep;
      const char* a2 = last ? nA : cA + (size_t)(t + 2) * kstep; const char* b2 = last ? nB : cB + (size_t)(t + 2) * kstep;
      const char* a3 = a2 + kstep; const char* b3 = b2 + kstep;
      PG8_LDB(B0, 0, 0); PG8_SCHED; PG8_LDA(At, 0, 0); PG8_STAGE(PG8_SA(1, 1), a1 + hstepA, voffA);
      PG8_WAIT_L(8); PG8_BAR; PG8_WAIT_L(0); PG8_MMA(0, 0, At, B0); PG8_BAR; PG8_SCHED;
      PG8_LDB(B1, 0, 1); PG8_STAGE(PG8_SB(0, 0), b2, voffB);
      PG8_BAR; PG8_WAIT_L(0); PG8_MMA(0, 1, At, B1); PG8_BAR;
      PG8_LDA(At, 0, 1); PG8_STAGE(PG8_SA(0, 0), a2, voffA);
      PG8_BAR; PG8_WAIT_L(0); PG8_MMA(1, 0, At, B0); PG8_BAR; PG8_SCHED;
      PG8_STAGE(PG8_SB(0, 1), b2 + hstepB, voffB);
      PG8_WAIT_V(6); PG8_BAR; PG8_MMA(1, 1, At, B1); PG8_BAR;
      PG8_LDB(B0, 1, 0); PG8_SCHED; PG8_LDA(At, 1, 0); PG8_STAGE(PG8_SA(0, 1), a2 + hstepA, voffA);
      PG8_WAIT_L(8); PG8_BAR; PG8_WAIT_L(0); PG8_MMA(0, 0, At, B0); PG8_BAR; PG8_SCHED;
      PG8_LDB(B1, 1, 1); PG8_STAGE(PG8_SB(1, 0), b3, voffB);
      PG8_BAR; PG8_WAIT_L(0); PG8_MMA(0, 1, At, B1); PG8_BAR;
      PG8_LDA(At, 1, 1); PG8_STAGE(PG8_SA(1, 0), a3, voffA);
      PG8_BAR; PG8_WAIT_L(0); PG8_MMA(1, 0, At, B0); PG8_BAR; PG8_SCHED;
      PG8_STAGE(PG8_SB(1, 1), b3 + hstepB, voffB);
      PG8_WAIT_V(6); PG8_BAR; PG8_MMA(1, 1, At, B1); PG8_BAR;
    }
    { int t2 = threadIdx.x; asm volatile("" : "+v"(t2)); const int w2 = __builtin_amdgcn_readfirstlane(t2 >> 6), l2 = t2 & 63; E(acc, cur, w2 >> 2, w2 & 3, l2 & 15, l2 >> 4); }
    if (!has_next) break;
    if (!Epi::CHAIN || nxt.which == 0 || nxt.pm >= 64) {
#pragma unroll
    for (int a = 0; a < 2; ++a)
#pragma unroll
      for (int b = 0; b < 2; ++b)
#pragma unroll
        for (int m = 0; m < 4; ++m)
#pragma unroll
          for (int n = 0; n < 2; ++n) acc[a][b][m][n] = (f32x4){0.f, 0.f, 0.f, 0.f};
    }
    cur = nxt; cA = nA; cB = nB; ++ui;
  }
  PG8_WAIT_V(0);
  if (wr == 0) PG8_BAR;
  PG8_BAR;
#undef PG8_SA
#undef PG8_SB
#undef PG8_STAGE
#undef PG8_LDA
#undef PG8_LDB
#undef PG8_MMA
#undef PG8_WAIT_V
#undef PG8_WAIT_L
#undef PG8_BAR
#undef PG8_SCHED
}
typedef f32x4 Acc[2][2][4][2];

template <class F>
DI void store_perm(const f32x4 (&acc)[2][2][4][2], bf16_t* O, int ldc, int rowt, int colt, int wr, int wc, int fr, int fq, const F& f, bool skip_bj1) {
  const int row0 = rowt + wr * 64 + fr, col0 = colt + wc * 32 + 8 * fq;
#pragma unroll
  for (int ai = 0; ai < 2; ++ai)
#pragma unroll
    for (int m = 0; m < 4; ++m) { bf16_t* rowp = O + (size_t)(row0 + ai * HALF + m * 16) * ldc + col0;
#pragma unroll
      for (int bj = 0; bj < 2; ++bj) { if (bj == 1 && skip_bj1) continue;
        const f32x4 v0 = acc[ai][bj][m][0], v1 = acc[ai][bj][m][1];
        u32x4 w; w.x = pk2(f(v0[0], bj, 0), f(v0[1], bj, 1)); w.y = pk2(f(v0[2], bj, 2), f(v0[3], bj, 3)); w.z = pk2(f(v1[0], bj, 4), f(v1[1], bj, 5)); w.w = pk2(f(v1[2], bj, 6), f(v1[3], bj, 7));
        *(u32x4*)(rowp + bj * HALF) = w; }
      asm volatile("" ::: "memory"); }
}

struct EpiPlain {
  static constexpr bool PERM = true, CHAIN = false;
  bf16_t* O; int ldc;
  DI void operator()(const f32x4 (&acc)[2][2][4][2], const Unit& u, int wr, int wc, int fr, int fq) const {
    store_perm(acc, O, ldc, u.pm * BM, u.pn * BM, wr, wc, fr, fq, [](float v, int, int) { return v; }, false);
  }
};
struct EpiIn {
  static constexpr bool PERM = true, CHAIN = false;
  unsigned char* ws;
  DI void operator()(const f32x4 (&acc)[2][2][4][2], const Unit& u, int wr, int wc, int fr, int fq) const {
    const int pn = u.pn, rowt = u.pm * BM;
    size_t off; int ld, colt, act = 0;
    if (u.which) { off = WS_VT; ld = NTOK; colt = pn * 256; }
    else if (pn < 12) { off = pn < 4 ? WS_AB : pn < 8 ? WS_AC : WS_AX; ld = 1024; colt = (pn & 3) * 256; }
    else if (pn < 24) { off = WS_RKV; ld = 3072; colt = (pn - 12) * 256; }
    else if (pn == 24) { off = WS_LACT; ld = 512; colt = 0; act = 1; }
    else if (pn == 25) { off = WS_LACT; ld = 512; colt = 256; act = 2; }
    else if (pn < 30) { off = WS_Q; ld = 1024; colt = (pn - 26) * 256; }
    else if (pn == 30) { off = WS_K; ld = 256; colt = 0; }
    else { off = WS_GATES; ld = 3072; colt = (pn - 31) * 256; act = 3; }
    if (act == 0) store_perm(acc, (bf16_t*)(ws + off), ld, rowt, colt, wr, wc, fr, fq, [](float v, int, int) { return v; }, false);
    else store_perm(acc, (bf16_t*)(ws + off), ld, rowt, colt, wr, wc, fr, fq, [act](float v, int bj, int) { const bool th = act == 1 && bj == 0; const float sg = sigmoidf_(th ? 2.0f * v : v); return (act == 1 && bj == 1) ? v : (th ? 2.0f * sg - 1.0f : sg); }, act == 2);
  }
};
struct LoraOrder {
  StaticOrder S;
  DI bool next(int i, Unit& u) const { if (!S.next(i, u)) return false; const int grp = u.pn >> 2; u.kt0 = grp < 2 ? 0 : (grp < 4 ? 2 : 4); u.nkt = 2; return true; }
};
struct EpiLora {
  static constexpr bool PERM = true, CHAIN = false;
  unsigned char* ws; const float* w0; const float* a0;
  DI void operator()(const f32x4 (&acc)[2][2][4][2], const Unit& u, int wr, int wc, int fr, int fq) const {
    const int grp = u.pn >> 2, colt = (u.pn & 3) * 256, rowt = u.pm * BM;
    bf16_t* O = (bf16_t*)(ws + WS_LOUT + (size_t)grp * SZ16);
    const int cbase = colt + wc * 32 + 8 * fq;
    if (grp < 4) { const float* bp = (grp < 2 ? w0 + grp * 1024 : a0 + (grp - 2) * 1024) + cbase; const float sc = grp < 2 ? 0.60653066f : 1.0f;
      const f32x4 b00 = *(const f32x4*)bp, b01 = *(const f32x4*)(bp + 4), b10 = *(const f32x4*)(bp + HALF), b11 = *(const f32x4*)(bp + HALF + 4);
      store_perm(acc, O, 1024, rowt, colt, wr, wc, fr, fq, [=](float v, int bj, int j) { const float bb = bj ? (j < 4 ? b10[j & 3] : b11[j & 3]) : (j < 4 ? b00[j & 3] : b01[j & 3]); return sc * sigmoidf_(v + bb); }, false); }
    else store_perm(acc, O, 1024, rowt, colt, wr, wc, fr, fq, [](float v, int, int) { return v; }, false);
  }
};
struct MergeOrder {
  StaticOrder S; int nctx;
  DI bool next(int i, Unit& u) const {
    const int R = (S.nwg + S.G - 1) / S.G;
    if (i < 3 * R) { if (!S.next(i / 3, u)) return false; u.which = i % 3; return true; }
    const int e = (i - 3 * R) * S.G + S.c; if (e >= nctx) return false;
    const int tile = e / 3;
    u.pm = 64 + (tile >> 2); u.pn = tile & 3; u.which = e - 3 * tile; u.kt0 = 0; u.nkt = 0; return true;
  }
};
struct EpiMergeChain {
  static constexpr bool PERM = true, CHAIN = true;
  unsigned char* ws;
  DI void operator()(f32x4 (&acc)[2][2][4][2], const Unit& u, int wr, int wc, int fr, int fq) const {
    const int row0 = u.pm * BM + wr * 64 + fr, col0 = u.pn * BM + wc * 32 + 8 * fq, br = u.which;
    const bf16_t* G = (const bf16_t*)(ws + WS_GATES) + br * 1024; bf16_t* M16 = (bf16_t*)(ws + WS_YB2);
    const bool isctx = u.pm >= 64;
    float* MP = (float*)(ws + WS_CPART) + (size_t)br * NTC * 1024 - (size_t)NTL * 1024;
#pragma unroll
    for (int ai = 0; ai < 2; ++ai)
#pragma unroll
      for (int m = 0; m < 4; ++m) { const size_t row = (size_t)(row0 + ai * HALF + m * 16);
#pragma unroll
        for (int bj = 0; bj < 2; ++bj) { const int c = col0 + bj * HALF;
          float f[8]; unpack8(*(const u32x4*)(G + row * 3072 + c), f);
          if (br < 2 && !isctx) { float h[8]; unpack8(*(const u32x4*)(G + row * 3072 + 1024 + c), h);
#pragma unroll
            for (int j = 0; j < 8; ++j) f[j] *= __builtin_amdgcn_rcpf(h[j]); }
          acc[ai][bj][m][0] *= (f32x4){f[0], f[1], f[2], f[3]}; acc[ai][bj][m][1] *= (f32x4){f[4], f[5], f[6], f[7]};
          if (isctx) { float* q = MP + row * 1024 + c; *(f32x4*)q = acc[ai][bj][m][0]; *(f32x4*)(q + 4) = acc[ai][bj][m][1]; }
          else if (br == 2) { const f32x4 v0 = acc[ai][bj][m][0], v1 = acc[ai][bj][m][1]; u32x4 w; w.x = pk2(v0[0], v0[1]); w.y = pk2(v0[2], v0[3]); w.z = pk2(v1[0], v1[1]); w.w = pk2(v1[2], v1[3]);
            *(u32x4*)(M16 + row * 1024 + c) = w; } }
        asm volatile("" ::: "memory"); }
  }
};
struct ResOrder {
  StaticOrder S; int nsplit, ks, nktq;
  DI bool next(int i, Unit& u) const {
    const long L = (long)i * S.G + S.c;
    int pm, pn, which = 0, kt0 = 0, nkt = 0;
    if (L < S.nwg) {
      int wgid = (int)L; { const int q = S.nwg / NXCD, r = S.nwg % NXCD, xcd = wgid % NXCD, off = wgid / NXCD; wgid = (xcd < r ? xcd * (q + 1) : r * (q + 1) + (xcd - r) * q) + off; }
      const int nig = WGM * S.nN, gid = wgid / nig, fm = gid * WGM, gsz = (S.nM - fm) < WGM ? (S.nM - fm) : WGM;
      pm = fm + ((wgid % nig) % gsz); pn = (wgid % nig) / gsz;
    } else {
      const int e = (int)L - S.nwg; if (e >= nsplit) return false;
      const int tile = e / ks, part = e - tile * ks;
      pm = 64 + (tile >> 2); pn = tile & 3; which = 1; kt0 = part * nktq; nkt = nktq;
    }
    u.pm = pm; u.pn = pn; u.which = which; u.kt0 = kt0; u.nkt = nkt; return true;
  }
};
struct EpiRes {
  static constexpr bool PERM = true, CHAIN = false;
  const float* baseL; const float* baseC; float* outL; float* outC; const float* mod;
  float* cpart; int nktq;
  DI void operator()(const f32x4 (&acc)[2][2][4][2], const Unit& u, int wr, int wc, int fr, int fq) const {
    const bool isc = u.pm >= 64; const int r3 = u.pm < 32 ? 0 : (u.pm < 64 ? 1 : 2);
    const float* base = isc ? baseC - (size_t)NTL * 1024 : baseL; float* out = isc ? outC - (size_t)NTL * 1024 : outL;
    const int row0 = u.pm * BM + wr * 64 + fr, col0 = u.pn * BM + wc * 32 + 8 * fq;
    const float* mv = mod + r3 * 6144;
    f32x4 g[2][2];
#pragma unroll
    for (int bj = 0; bj < 2; ++bj)
#pragma unroll
      for (int n = 0; n < 2; ++n) g[bj][n] = *(const f32x4*)(mv + col0 + bj * HALF + 4 * n);
#pragma unroll
    for (int ai = 0; ai < 2; ++ai)
#pragma unroll
      for (int m = 0; m < 4; ++m) { const size_t off = (size_t)(row0 + ai * HALF + m * 16) * 1024;
#pragma unroll
        for (int bj = 0; bj < 2; ++bj)
#pragma unroll
          for (int n = 0; n < 2; ++n) { const int c = col0 + bj * HALF + 4 * n;
            const f32x4 v = g[bj][n] * acc[ai][bj][m][n];
            if (u.which) { *(f32x4*)(cpart + (size_t)(u.kt0 / nktq) * NTC * 1024 + (off - (size_t)NTL * 1024) + c) = v; }
            else { const f32x4 b = *(const f32x4*)(base + off + c); *(f32x4*)(out + off + c) = b + v; } }
        asm volatile("" ::: "memory"); }
  }
};
}
struct Ctx { int tid, lane, wave, bid, nb; unsigned char* lds; };

struct CvtTile { bf16_t* dst; const float* src; int ldd, ldsrc; };
DI CvtTile cvt_decode(PP p, int l, int t) {
  unsigned char* ws = p->ws; CvtTile r;
  if (t < 2816) { const int nt = t >> 4, kt = t & 15; const int n0 = nt * 64, k0 = kt * 64;
    const float* W = p->in[7] + (size_t)l * 1024 * NIN;
    bf16_t* dst; int srccol;
    if (n0 < 6528) { dst = (bf16_t*)(ws + WS_WIN) + (size_t)n0 * 1024; srccol = n0; }
    else if (n0 < 6656) { dst = (bf16_t*)(ws + WS_WIN) + (size_t)n0 * 1024; srccol = -1; }
    else if (n0 < 7936) { dst = (bf16_t*)(ws + WS_WIN) + (size_t)n0 * 1024; srccol = n0 - 128; }
    else if (n0 < 11008) { dst = (bf16_t*)(ws + WS_WIN) + (size_t)n0 * 1024; srccol = n0 - 7936 + 8064; }
    else { dst = (bf16_t*)(ws + WS_WV) + (size_t)(n0 - 11008) * 1024; srccol = n0 - 11008 + 7808; }
    r.dst = dst + k0; r.ldd = 1024; r.src = srccol < 0 ? nullptr : W + (size_t)k0 * NIN + srccol; r.ldsrc = NIN;
  } else if (t < 3296) { const int u = t - 2816, nt = u / 6, kt = u % 6; const int n0 = nt * 64, k0 = kt * 64, grp = n0 >> 10, nc = n0 & 1023;
    const float* src = nullptr;
    if (grp < 2) { if (kt == grp) src = p->in[12] + ((size_t)(l * 2 + grp) * 64) * 1024 + nc; }
    else if (grp < 4) { if (kt == grp) src = p->in[14] + ((size_t)(l * 2 + grp - 2) * 64) * 1024 + nc; }
    else { if (kt >= 4) src = p->in[15] + ((size_t)l * 128 + (kt - 4) * 64) * 1024 + nc; }
    r.dst = (bf16_t*)(ws + WS_WLORA) + (size_t)n0 * 384 + k0; r.ldd = 384; r.src = src; r.ldsrc = 1024;
  } else if (t < 4320) { const int u = t - 3296, which = u >> 8, v = u & 255, nt = v >> 4, kt = v & 15;
    const int idx = which == 0 ? 9 : which == 1 ? 21 : which == 2 ? 23 : 24;
    const float* W = p->in[idx] + (size_t)l * 1024 * 1024;
    r.dst = (bf16_t*)(ws + WS_WA + (size_t)which * AL((size_t)1024 * 1024 * 2)) + (size_t)(nt * 64) * 1024 + kt * 64; r.ldd = 1024; r.src = W + (size_t)(kt * 64) * 1024 + nt * 64; r.ldsrc = 1024;
  } else if (t < 5728) { const int u = t - 4320, nt = u >> 4, kt = u & 15;
    const float* W = p->in[26] + (size_t)l * 1024 * 5632;
    r.dst = (bf16_t*)(ws + WS_WUP) + (size_t)(nt * 64) * 1024 + kt * 64; r.ldd = 1024; r.src = W + (size_t)(kt * 64) * 5632 + nt * 64; r.ldsrc = 5632;
  } else { const int u = t - 5728, nt = u / 44, kt = u % 44;
    const float* W = p->in[28] + (size_t)l * 2816 * 1024;
    r.dst = (bf16_t*)(ws + WS_WDN) + (size_t)(nt * 64) * 2816 + kt * 64; r.ldd = 2816; r.src = W + (size_t)(kt * 64) * 1024 + nt * 64; r.ldsrc = 1024;
  }
  return r;
}
DI void phase_convert(const Ctx& c, PP p, int l) {
  float* ta = (float*)c.lds; float* tb = ta + 64 * 65;
  for (int t = c.bid; t < 6432; t += 2 * c.nb) {
    const bool two = t + c.nb < 6432;
    const CvtTile A = cvt_decode(p, l, t), B = cvt_decode(p, l, two ? t + c.nb : t);
    if (A.src) {
#pragma unroll
      for (int i = 0; i < 8; ++i) { const int e = c.tid + i * NTHR, kk = e >> 6, nn = e & 63; ta[kk * 65 + nn] = A.src[(size_t)kk * A.ldsrc + nn]; } }
    if (two && B.src) {
#pragma unroll
      for (int i = 0; i < 8; ++i) { const int e = c.tid + i * NTHR, kk = e >> 6, nn = e & 63; tb[kk * 65 + nn] = B.src[(size_t)kk * B.ldsrc + nn]; } }
    __syncthreads();
#pragma unroll
    for (int i = 0; i < 4; ++i) { const int e = c.tid + i * NTHR, nn = e >> 5, kp = e & 31;
      unsigned w = 0u; if (A.src) w = pk2(ta[(2 * kp) * 65 + nn], ta[(2 * kp + 1) * 65 + nn]);
      *(unsigned*)(A.dst + (size_t)nn * A.ldd + 2 * kp) = w; }
    if (two) {
#pragma unroll
      for (int i = 0; i < 4; ++i) { const int e = c.tid + i * NTHR, nn = e >> 5, kp = e & 31;
        unsigned w = 0u; if (B.src) w = pk2(tb[(2 * kp) * 65 + nn], tb[(2 * kp + 1) * 65 + nn]);
        *(unsigned*)(B.dst + (size_t)nn * B.ldd + 2 * kp) = w; } }
    __syncthreads();
  }
}

DI void phase_mods(const Ctx& c, PP p) {
  float* s = (float*)c.lds;
  float* red = s + 3 * 1024;
  for (int i = c.tid; i < 3072; i += NTHR) { const float v = i < 2048 ? p->in[1][i] : p->in[3][i - 2048]; s[i] = v * sigmoidf_(v); }
  __syncthreads();
  float* mod = (float*)(p->ws + WS_MOD);
  const int col = c.tid & 63, kg = c.tid >> 6;
  for (int it = c.bid; it < DEPTH * 96; it += c.nb) {
    const int l = it / 96, j0 = (it % 96) * 64;
    const float* W = p->in[4] + (size_t)l * 1024 * 6144 + j0 + col;
    float a0 = 0.f, a1 = 0.f, a2 = 0.f;
#pragma unroll 8
    for (int k = kg * 128; k < kg * 128 + 128; ++k) { const float w = W[(size_t)k * 6144]; a0 += s[k] * w; a1 += s[1024 + k] * w; a2 += s[2048 + k] * w; }
    red[(kg * 3 + 0) * 64 + col] = a0; red[(kg * 3 + 1) * 64 + col] = a1; red[(kg * 3 + 2) * 64 + col] = a2;
    __syncthreads();
    if (c.tid < 192) { const int r = c.tid >> 6; float v = p->in[5][(size_t)l * 6144 + j0 + col];
#pragma unroll
      for (int g = 0; g < 8; ++g) v += red[(g * 3 + r) * 64 + col];
      mod[((size_t)l * 3 + r) * 6144 + j0 + col] = v; }
    __syncthreads();
  }
  { float* xcd = (float*)(p->ws + WS_XC); const float* cx = p->in[2];
    for (int i = c.bid * NTHR + c.tid; i < NTC * 1024 / 4; i += c.nb * NTHR) ((f32x4*)xcd)[i] = ((const f32x4*)cx)[i]; }
  const int gt = c.bid * NTHR + c.tid;
  if (gt < 2048) { const int pos = gt >> 4, f = gt & 15; const float inv = powf(10000.0f, -(float)f / 16.0f); const float ang = (float)pos * inv;
    float* rope = (float*)(p->ws + WS_ROPE); rope[gt] = cosf(ang); rope[2048 + gt] = sinf(ang); }
}

DI void phase_norm(const Ctx& c, PP p, const float* xL, float* xC, const float* g, const float* mod  , int shift_idx, int npart) {
  const float* cpart = (const float*)(p->ws + WS_CPART);
  bf16_t* H = (bf16_t*)(p->ws + WS_H);
  for (int row = c.bid * 8 + c.wave; row < NTOK; row += c.nb * 8) {
    const float* xr = row < NTL ? xL + (size_t)row * 1024 : xC + (size_t)(row - NTL) * 1024;
    const int r3 = row < SEQ ? 0 : (row < NTL ? 1 : 2);
    const float* sh = mod + r3 * 6144 + shift_idx * 1024; const float* sc = sh + 1024;
    f32x4 v[4]; float ss = 0.f;
#pragma unroll
    for (int i = 0; i < 4; ++i) { v[i] = *(const f32x4*)(xr + i * 256 + c.lane * 4);
      if (row >= NTL && npart > 0) {
        for (int q = 0; q < npart; ++q) v[i] += *(const f32x4*)(cpart + ((size_t)q * NTC + (row - NTL)) * 1024 + i * 256 + c.lane * 4);
        *(f32x4*)(xC + (size_t)(row - NTL) * 1024 + i * 256 + c.lane * 4) = v[i]; }
      ss += v[i][0] * v[i][0] + v[i][1] * v[i][1] + v[i][2] * v[i][2] + v[i][3] * v[i][3]; }
    ss = wave_sum(ss);
    const float rs = rsqrtf(ss * (1.0f / 1024.0f) + 1e-6f);
#pragma unroll
    for (int i = 0; i < 4; ++i) { const int col = i * 256 + c.lane * 4;
      const f32x4 gg = *(const f32x4*)(g + col), s1 = *(const f32x4*)(sc + col), s0 = *(const f32x4*)(sh + col);
      const f32x4 h = v[i] * rs * gg * (1.0f + s1) + s0;
      u32x2 w; w.x = pk2(h[0], h[1]); w.y = pk2(h[2], h[3]); *(u32x2*)(H + (size_t)row * 1024 + col) = w; }
  }
}

DI void phase_final(const Ctx& c, PP p, float dpert) {
  const float* g = p->in[29];
  for (int row = c.bid * 8 + c.wave; row < NTL; row += c.nb * 8) {
    float* xr = p->out + (size_t)row * 1024;
    f32x4 v[4]; float ss = 0.f;
#pragma unroll
    for (int i = 0; i < 4; ++i) { v[i] = *(const f32x4*)(xr + i * 256 + c.lane * 4); ss += v[i][0] * v[i][0] + v[i][1] * v[i][1] + v[i][2] * v[i][2] + v[i][3] * v[i][3]; }
    ss = wave_sum(ss);
    const float rs = rsqrtf(ss * (1.0f / 1024.0f) + 1e-6f);
#pragma unroll
    for (int i = 0; i < 4; ++i) { const int col = i * 256 + c.lane * 4; const float sg = (row & 1) ? dpert : -dpert; *(f32x4*)(xr + col) = v[i] * rs * *(const f32x4*)(g + col) + (f32x4){sg, -sg, sg, -sg}; }
  }
}

DI void ld8f(const float* p, float (&f)[8]) { const f32x4 a = *(const f32x4*)p, b = *(const f32x4*)(p + 4); f[0] = a[0]; f[1] = a[1]; f[2] = a[2]; f[3] = a[3]; f[4] = b[0]; f[5] = b[1]; f[6] = b[2]; f[7] = b[3]; }
DI void seq_of_row(int row0, int& pos0, int& seqlen) { if (row0 < NTL) { pos0 = row0 & (SEQ - 1); seqlen = SEQ; } else { pos0 = (row0 - NTL) & (CTXL - 1); seqlen = CTXL; } }

DI void phase_conv_a(const Ctx& c, PP p, int l) {
  bf16_t* AB = (bf16_t*)(p->ws + WS_AB); const bf16_t* AC = (const bf16_t*)(p->ws + WS_AC); const bf16_t* AX = (const bf16_t*)(p->ws + WS_AX);
  const float* cw = p->in[8] + (size_t)l * 3 * 1024;
  const int nitems = (NTOK / 8) * 128;
  for (int it = c.bid * NTHR + c.tid; it < nitems; it += c.nb * NTHR) {
    const int rb = it >> 7, ch = it & 127, row0 = rb * 8, col = ch * 8; int pos0, seqlen; seq_of_row(row0, pos0, seqlen);
    float w0[8], w1[8], w2[8];
#pragma unroll
    for (int j = 0; j < 8; ++j) { w0[j] = cw[col + j]; w1[j] = cw[1024 + col + j]; w2[j] = cw[2048 + col + j]; }
    float zp[8], zc[8], zn[8];
    auto loadz = [&](int row, float (&z)[8]) { float a[8], b[8]; unpack8(*(const u32x4*)(AC + (size_t)row * 1024 + col), a); unpack8(*(const u32x4*)(AX + (size_t)row * 1024 + col), b);
#pragma unroll
      for (int j = 0; j < 8; ++j) z[j] = a[j] * b[j]; };
    if (pos0 > 0) loadz(row0 - 1, zp); else {
#pragma unroll
      for (int j = 0; j < 8; ++j) zp[j] = 0.f; }
    loadz(row0, zc);
#pragma unroll
    for (int r = 0; r < 8; ++r) {
      if (pos0 + r + 1 < seqlen) loadz(row0 + r + 1, zn); else {
#pragma unroll
        for (int j = 0; j < 8; ++j) zn[j] = 0.f; }
      float b[8]; unpack8(*(const u32x4*)(AB + (size_t)(row0 + r) * 1024 + col), b);
      float o[8];
#pragma unroll
      for (int j = 0; j < 8; ++j) { o[j] = b[j] * (zp[j] * w0[j] + zc[j] * w1[j] + zn[j] * w2[j]); zp[j] = zc[j]; zc[j] = zn[j]; }
      u32x4 w; w.x = pk2(o[0], o[1]); w.y = pk2(o[2], o[3]); w.z = pk2(o[4], o[5]); w.w = pk2(o[6], o[7]);
      *(u32x4*)(AB + (size_t)(row0 + r) * 1024 + col) = w;
    }
  }
}

DI void phase_ffn_act(const Ctx& c, PP p, int l) {
  const bf16_t* U = (const bf16_t*)(p->ws + WS_U); bf16_t* ACT = (bf16_t*)(p->ws + WS_GATES);
  const float* cw = p->in[27] + (size_t)l * 3 * 5632;
  const int nrows = (l == DEPTH - 1) ? NTL : NTOK;
  const int nitems = (nrows / 8) * 352;
  for (int it = c.bid * NTHR + c.tid; it < nitems; it += c.nb * NTHR) {
    const int rb = it / 352, ch = it % 352, row0 = rb * 8, col = ch * 8; int pos0, seqlen; seq_of_row(row0, pos0, seqlen);
    const bool hp = pos0 > 0, hn = pos0 + 8 < seqlen;
    u32x4 rg[10], rv[10];
#pragma unroll
    for (int r = 0; r < 10; ++r) { int row = row0 - 1 + r; row = (r == 0 && !hp) ? row0 : row; row = (r == 9 && !hn) ? row0 + 7 : row;
      rg[r] = *(const u32x4*)(U + (size_t)row * 5632 + col); rv[r] = *(const u32x4*)(U + (size_t)row * 5632 + 2816 + col); }
    if (!hp) { rg[0] = (u32x4){0u, 0u, 0u, 0u}; rv[0] = rg[0]; }
    if (!hn) { rg[9] = (u32x4){0u, 0u, 0u, 0u}; rv[9] = rg[9]; }
    float wg[3][8], wv[3][8];
#pragma unroll
    for (int i = 0; i < 3; ++i) { ld8f(cw + i * 5632 + col, wg[i]); ld8f(cw + i * 5632 + 2816 + col, wv[i]); }
    float gp[8], gc[8], gn[8], vp[8], vc[8], vn[8];
    unpack8(rg[0], gp); unpack8(rv[0], vp); unpack8(rg[1], gc); unpack8(rv[1], vc);
#pragma unroll
    for (int r = 0; r < 8; ++r) {
      unpack8(rg[r + 2], gn); unpack8(rv[r + 2], vn);
      float o[8];
#pragma unroll
      for (int j = 0; j < 8; ++j) {
        const float ug = gp[j] * wg[0][j] + gc[j] * wg[1][j] + gn[j] * wg[2][j];
        const float uv = vp[j] * wv[0][j] + vc[j] * wv[1][j] + vn[j] * wv[2][j];
        o[j] = ug * sigmoidf_(ug) * uv; gp[j] = gc[j]; gc[j] = gn[j]; vp[j] = vc[j]; vc[j] = vn[j]; }
      u32x4 w; w.x = pk2(o[0], o[1]); w.y = pk2(o[2], o[3]); w.z = pk2(o[4], o[5]); w.w = pk2(o[6], o[7]);
      *(u32x4*)(ACT + (size_t)(row0 + r) * 2816 + col) = w;
    }
  }
}

DI float red8(float x) {
  x += __builtin_bit_cast(float, __builtin_amdgcn_update_dpp(0, __builtin_bit_cast(int, x), 0xB1, 0xf, 0xf, false));
  x += __builtin_bit_cast(float, __builtin_amdgcn_update_dpp(0, __builtin_bit_cast(int, x), 0x4E, 0xf, 0xf, false));
  x += __builtin_bit_cast(float, __builtin_amdgcn_update_dpp(0, __builtin_bit_cast(int, x), 0x141, 0xf, 0xf, false));
  return x;
}
DI void phase_rwkv_fin(const Ctx& c, PP p, int l) {
  bf16_t* YF = (bf16_t*)(p->ws + WS_H); const bf16_t* YB = (const bf16_t*)(p->ws + WS_YB2); const bf16_t* RKV = (const bf16_t*)(p->ws + WS_RKV);
  const bf16_t* AS0 = (const bf16_t*)(p->ws + WS_LOUT + 2 * SZ16); const bf16_t* AS1 = (const bf16_t*)(p->ws + WS_LOUT + 3 * SZ16); const bf16_t* GG = (const bf16_t*)(p->ws + WS_LOUT + 4 * SZ16);
  const int gw = c.bid * 8 + c.wave, half = gw & 1, ch0 = half * 512 + c.lane * 8;
  float m0[3][8], m1[3][8], kav[8], rkv_[8], lgv[8], lbv[8];
  { const float* mu = p->in[10] + (size_t)l * 2 * 3072;
#pragma unroll
    for (int q = 0; q < 3; ++q) { ld8f(mu + q * 1024 + ch0, m0[q]); ld8f(mu + 3072 + q * 1024 + ch0, m1[q]); }
    ld8f(p->in[17] + (size_t)l * 1024 + ch0, kav); ld8f(p->in[18] + (size_t)l * 1024 + ch0, rkv_); ld8f(p->in[19] + (size_t)l * 1024 + ch0, lgv); ld8f(p->in[20] + (size_t)l * 1024 + ch0, lbv); }
  const int ntok = (l == DEPTH - 1) ? NTL : NTOK;
  for (int row = gw >> 1; row < ntok; row += c.nb * 4) {
    int pos, seqlen; seq_of_row(row, pos, seqlen);
    const float mp = pos > 0 ? 1.f : 0.f, mn = pos + 1 < seqlen ? 1.f : 0.f;
    const bf16_t* r0 = RKV + (size_t)(pos > 0 ? row - 1 : row) * 3072 + ch0; const bf16_t* r1 = RKV + (size_t)row * 3072 + ch0; const bf16_t* r2 = RKV + (size_t)(pos + 1 < seqlen ? row + 1 : row) * 3072 + ch0;
    float x[3][8];
#pragma unroll
    for (int q = 0; q < 3; ++q) { float a[8], b[8], d[8]; unpack8(*(const u32x4*)(r0 + q * 1024), a); unpack8(*(const u32x4*)(r1 + q * 1024), b); unpack8(*(const u32x4*)(r2 + q * 1024), d);
#pragma unroll
      for (int j = 0; j < 8; ++j) x[q][j] = mp * m0[q][j] * a[j] + (1.0f - m0[q][j] - m1[q][j]) * b[j] + mn * m1[q][j] * d[j]; }
    const size_t o = (size_t)row * 1024 + ch0;
    float a0[8], a1[8], yf[8], yb[8], gg[8];
    unpack8(*(const u32x4*)(AS0 + o), a0); unpack8(*(const u32x4*)(AS1 + o), a1); unpack8(*(const u32x4*)(YF + o), yf); unpack8(*(const u32x4*)(YB + o), yb); unpack8(*(const u32x4*)(GG + o), gg);
    float s01 = 0.f, sy = 0.f, y[8];
#pragma unroll
    for (int j = 0; j < 8; ++j) { const float kd0 = x[1][j] * (1.0f + (a0[j] - 1.0f) * kav[j]), kd1 = x[1][j] * (1.0f + (a1[j] - 1.0f) * kav[j]);
      s01 += x[0][j] * rkv_[j] * (kd0 + kd1); y[j] = yf[j] + yb[j]; sy += y[j]; }
    s01 = red8(s01); sy = red8(sy);
    const float mean = sy * (1.0f / 64.0f); float sq = 0.f;
#pragma unroll
    for (int j = 0; j < 8; ++j) { y[j] -= mean; sq += y[j] * y[j]; }
    sq = red8(sq);
    const float rstd = rsqrtf(sq * (1.0f / 64.0f) + 64e-5f);
    float ov[8];
#pragma unroll
    for (int j = 0; j < 8; ++j) ov[j] = (y[j] * rstd * lgv[j] + lbv[j] + s01 * x[2][j]) * gg[j];
    u32x4 w; w.x = pk2(ov[0], ov[1]); w.y = pk2(ov[2], ov[3]); w.z = pk2(ov[4], ov[5]); w.w = pk2(ov[6], ov[7]);
    *(u32x4*)(YF + o) = w;
  }
}

DI void phase_mctx(const Ctx& c, PP p) {
  const float* MP = (const float*)(p->ws + WS_CPART); bf16_t* M16 = (bf16_t*)(p->ws + WS_YB2) + (size_t)NTL * 1024;
  for (int i = c.bid * NTHR + c.tid; i < NTC * 1024 / 4; i += c.nb * NTHR) {
    const f32x4 v = *(const f32x4*)(MP + (size_t)i * 4) + *(const f32x4*)(MP + (size_t)NTC * 1024 + (size_t)i * 4) + *(const f32x4*)(MP + (size_t)2 * NTC * 1024 + (size_t)i * 4);
    u32x2 w; w.x = pk2(v[0], v[1]); w.y = pk2(v[2], v[3]); *(u32x2*)(M16 + (size_t)i * 4) = w;
  }
}
#define MFMA32(a, b, c) __builtin_amdgcn_mfma_f32_32x32x16_bf16((a), (b), (c), 0, 0, 0)
constexpr int KS_LD = 72, VS_LD = 136;
constexpr float QSCALE = 0.125f * 1.4426950408889634f;

DI void attn_unit(const Ctx& c, PP p, int l, int unit) {
  bf16_t* Ks = (bf16_t*)c.lds; bf16_t* Vs = Ks + 128 * KS_LD;
  const bf16_t* Q = (const bf16_t*)(p->ws + WS_Q); const bf16_t* Kg = (const bf16_t*)(p->ws + WS_K); const bf16_t* Vt = (const bf16_t*)(p->ws + WS_VT);
  bf16_t* O = (bf16_t*)(p->ws + WS_Q);
  const float* ropec = (const float*)(p->ws + WS_ROPE); const float* ropes = ropec + 2048;
  const bool isctx = unit >= 512;
  int b, n, g, qrow0;
  if (!isctx) { b = unit >> 8; n = (unit >> 2) & 63; g = unit & 3; qrow0 = b * SEQ + n * 128; }
  else { const int uu = unit - 512; b = uu >> 3; n = (uu >> 2) & 1; g = uu & 3; qrow0 = NTL + b * CTXL + n * 128; }
  const int lane = c.lane, w = c.wave, r = lane & 31, h = lane >> 5;
  const int head = 4 * g + (w >> 1), qoff = 64 * (w & 1);
  bf16x8 qf[2][4];
#pragma unroll
  for (int tl = 0; tl < 2; ++tl) {
    const int qi = qoff + 32 * tl + r, tr = qrow0 + qi;
    const bf16_t* qp = Q + (size_t)tr * 1024 + head * 64 + 8 * h;
    float x[4][8];
#pragma unroll
    for (int s = 0; s < 4; ++s) unpack8(*(const u32x4*)(qp + 16 * s), x[s]);
    if (!isctx) {
      const int t = n * 128 + qi; const int pr = t >> 6, pc = t & 63;
#pragma unroll
      for (int ax = 0; ax < 2; ++ax) { const int pos = ax ? pc : pr;
#pragma unroll
        for (int j = 0; j < 8; ++j) { const float cs = ropec[pos * 16 + 8 * h + j], sn = ropes[pos * 16 + 8 * h + j];
          const float x1 = x[2 * ax][j], x2 = x[2 * ax + 1][j]; x[2 * ax][j] = x1 * cs - x2 * sn; x[2 * ax + 1][j] = x1 * sn + x2 * cs; } }
    }
#pragma unroll
    for (int s = 0; s < 4; ++s) { u32x4 wv; wv.x = pk2(x[s][0] * QSCALE, x[s][1] * QSCALE); wv.y = pk2(x[s][2] * QSCALE, x[s][3] * QSCALE); wv.z = pk2(x[s][4] * QSCALE, x[s][5] * QSCALE); wv.w = pk2(x[s][6] * QSCALE, x[s][7] * QSCALE);
      qf[tl][s] = __builtin_bit_cast(bf16x8, wv); }
  }
  f32x16 oacc[2][2];
  float mrun[2], lrun[2];
#pragma unroll
  for (int tl = 0; tl < 2; ++tl) { mrun[tl] = -1e30f; lrun[tl] = 0.f;
#pragma unroll
    for (int dh = 0; dh < 2; ++dh)
#pragma unroll
      for (int i = 0; i < 16; ++i) oacc[tl][dh][i] = 0.f; }
  const int ntile = isctx ? 2 : 5;
  auto tile_valid = [&](int ti) { return isctx || !((ti == 1 && n == 0) || (ti == 2 && n == 63)); };
  auto tile_row0 = [&](int ti) { return isctx ? NTL + b * CTXL + ti * 128 : (ti == 0 ? b * SEQ + n * 128 : ti == 1 ? b * SEQ + (n - 1) * 128 : ti == 2 ? b * SEQ + (n + 1) * 128 : NTL + b * CTXL + (ti - 3) * 128); };
  const int kr = c.tid >> 2, pcx = c.tid & 3, c1 = (pcx & 1) + 4 * (pcx >> 1), kax = pcx >> 1;
  u32x4 pk1, pk2_, pv0, pv1;
  auto prefetch = [&](int ti) { const int krow0 = tile_row0(ti);
    const bf16_t* kp = Kg + (size_t)(krow0 + kr) * 256 + g * 64; pk1 = *(const u32x4*)(kp + 8 * c1); pk2_ = *(const u32x4*)(kp + 8 * c1 + 16);
    pv0 = *(const u32x4*)(Vt + (size_t)(g * 64 + (c.tid >> 4)) * NTOK + krow0 + 8 * (c.tid & 15));
    pv1 = *(const u32x4*)(Vt + (size_t)(g * 64 + 32 + (c.tid >> 4)) * NTOK + krow0 + 8 * (c.tid & 15)); };
  prefetch(0);
  for (int ti = 0; ti < ntile; ++ti) {
    if (!tile_valid(ti)) continue;
    const int krow0 = tile_row0(ti);
    const int mode = (!isctx && ti == 1) ? 1 : ((!isctx && ti == 2) ? 2 : 0);
    const bool rope = !isctx && ti < 3;
    __syncthreads();
    {
      float x1[8], x2[8]; unpack8(pk1, x1); unpack8(pk2_, x2);
      if (rope) { const int t = (krow0 + kr) & (SEQ - 1); const int pos = kax ? (t & 63) : (t >> 6); const int f0 = 8 * (pcx & 1);
#pragma unroll
        for (int j = 0; j < 8; ++j) { const float cs = ropec[pos * 16 + f0 + j], sn = ropes[pos * 16 + f0 + j]; const float a = x1[j], bb = x2[j]; x1[j] = a * cs - bb * sn; x2[j] = a * sn + bb * cs; } }
      u32x4 w1, w2; w1.x = pk2(x1[0], x1[1]); w1.y = pk2(x1[2], x1[3]); w1.z = pk2(x1[4], x1[5]); w1.w = pk2(x1[6], x1[7]);
      w2.x = pk2(x2[0], x2[1]); w2.y = pk2(x2[2], x2[3]); w2.z = pk2(x2[4], x2[5]); w2.w = pk2(x2[6], x2[7]);
      *(u32x4*)(Ks + kr * KS_LD + 8 * c1) = w1; *(u32x4*)(Ks + kr * KS_LD + 8 * c1 + 16) = w2;
      *(u32x4*)(Vs + (c.tid >> 4) * VS_LD + 8 * (c.tid & 15)) = pv0; *(u32x4*)(Vs + (32 + (c.tid >> 4)) * VS_LD + 8 * (c.tid & 15)) = pv1;
    }
    __syncthreads();
    { int tn = ti + 1; while (tn < ntile && !tile_valid(tn)) ++tn; if (tn < ntile) prefetch(tn); }
#pragma unroll 1
    for (int ks = 0; ks < 4; ++ks) {
      bf16x8 kf[4];
#pragma unroll
      for (int s = 0; s < 4; ++s) kf[s] = *(const bf16x8*)(Ks + (32 * ks + r) * KS_LD + 16 * s + 8 * h);
      bf16x8 vf[2][2];
#pragma unroll
      for (int dh = 0; dh < 2; ++dh)
#pragma unroll
        for (int s = 0; s < 2; ++s) { const bf16_t* vp = Vs + (32 * dh + r) * VS_LD + 32 * ks + 16 * s + 4 * h;
          const s16x4 lo = *(const s16x4*)vp, hi = *(const s16x4*)(vp + 8); vf[dh][s] = __builtin_shufflevector(lo, hi, 0, 1, 2, 3, 4, 5, 6, 7); }
#pragma unroll
      for (int tl = 0; tl < 2; ++tl) {
        { const int q0 = qoff + 32 * tl; if ((mode == 1 && 32 * ks + 31 < q0) || (mode == 2 && 32 * ks > q0 + 31)) continue; }
        f32x16 x;
#pragma unroll
        for (int i = 0; i < 16; ++i) x[i] = 0.f;
#pragma unroll
        for (int s = 0; s < 4; ++s) x = MFMA32(kf[s], qf[tl][s], x);
        const int qi = qoff + 32 * tl + r;
        if (mode) {
#pragma unroll
          for (int i = 0; i < 16; ++i) { const int kj = 32 * ks + (i & 3) + 8 * (i >> 2) + 4 * h; const bool ok = mode == 1 ? (kj >= qi) : (kj <= qi); x[i] = ok ? x[i] : -1e30f; }
        }
        float mx = x[0];
#pragma unroll
        for (int i = 1; i < 16; ++i) mx = fmaxf(mx, x[i]);
        mx = fmaxf(mx, __shfl_xor(mx, 32));
        const float mnew = fmaxf(mrun[tl], mx), alpha = __builtin_amdgcn_exp2f(mrun[tl] - mnew);
        float ps = 0.f;
#pragma unroll
        for (int i = 0; i < 16; ++i) { x[i] = __builtin_amdgcn_exp2f(x[i] - mnew); ps += x[i]; }
        ps += __shfl_xor(ps, 32);
        lrun[tl] = lrun[tl] * alpha + ps; mrun[tl] = mnew;
        if (__any(alpha != 1.0f)) {
#pragma unroll
          for (int dh = 0; dh < 2; ++dh)
#pragma unroll
            for (int i = 0; i < 16; ++i) oacc[tl][dh][i] *= alpha;
        }
#pragma unroll
        for (int s = 0; s < 2; ++s) { u32x4 pw; pw.x = pk2(x[8 * s], x[8 * s + 1]); pw.y = pk2(x[8 * s + 2], x[8 * s + 3]); pw.z = pk2(x[8 * s + 4], x[8 * s + 5]); pw.w = pk2(x[8 * s + 6], x[8 * s + 7]);
          const bf16x8 pf = __builtin_bit_cast(bf16x8, pw);
          oacc[tl][0] = MFMA32(vf[0][s], pf, oacc[tl][0]); oacc[tl][1] = MFMA32(vf[1][s], pf, oacc[tl][1]); }
      }
    }
  }
  const float sink = p->in[22][l * 16 + head] * 1.4426950408889634f;
#pragma unroll
  for (int tl = 0; tl < 2; ++tl) {
    const float lt = lrun[tl] + __builtin_amdgcn_exp2f(sink - mrun[tl]); const float inv = 1.0f / lt;
    const int tr = qrow0 + qoff + 32 * tl + r;
    bf16_t* op = O + (size_t)tr * 1024 + head * 64;
#pragma unroll
    for (int dh = 0; dh < 2; ++dh)
#pragma unroll
      for (int gq = 0; gq < 4; ++gq) { u32x2 wv; wv.x = pk2(oacc[tl][dh][4 * gq] * inv, oacc[tl][dh][4 * gq + 1] * inv); wv.y = pk2(oacc[tl][dh][4 * gq + 2] * inv, oacc[tl][dh][4 * gq + 3] * inv);
        *(u32x2*)(op + 32 * dh + 8 * gq + 4 * h) = wv; }
  }
  __syncthreads();
}

constexpr int SC_CH = 48;
constexpr int SC_STEP_F = 5 * 64 + 16;
constexpr int SC_BUF_F = SC_CH * SC_STEP_F;
constexpr int SC_NCHUNK = (CTXL + SEQ) / SC_CH;

constexpr int SC_NIT = SC_CH / 8;
struct ScanRegs { unsigned rk[SC_NIT][9]; unsigned ev[SC_NIT], av[SC_NIT]; };

DI int scan_row(int s, int dir, int b, int& pos, int& seqlen) {
  if (s < CTXL) { pos = dir ? CTXL - 1 - s : s; seqlen = CTXL; return NTL + b * CTXL + pos; }
  const int s2 = s - CTXL; pos = dir ? SEQ - 1 - s2 : s2; seqlen = SEQ; return b * SEQ + pos;
}

DI void phase_scan(const Ctx& c, PP p, int l) {
  float* bufs = (float*)c.lds;
  float* ybuf = bufs + 2 * SC_BUF_F;
  const int xcd = c.bid & 7, slot = c.bid >> 3;
  const int chain = xcd * 8 + (slot >> 2), part = slot & 3;
  const int dir = chain >> 5, b = (chain >> 4) & 1, hd = chain & 15;
  const bf16_t* RKV = (const bf16_t*)(p->ws + WS_RKV);
  const bf16_t* EE = (const bf16_t*)(p->ws + WS_LOUT + (size_t)dir * SZ16); const bf16_t* AS = (const bf16_t*)(p->ws + WS_LOUT + (size_t)(2 + dir) * SZ16);
  bf16_t* Y = (bf16_t*)(p->ws + (dir ? WS_YB2 : WS_H));
  const bool loader = c.wave >= 4;
  const int lt = c.tid - 256, lw = lt >> 6, half = (c.lane >> 5), cp = c.lane & 31;
  float mu0[3][2], mu1[3][2], kkw[2], kaw[2];
  if (loader) {
    const float* mu = p->in[10] + (size_t)l * 2 * 3072;
#pragma unroll
    for (int q = 0; q < 3; ++q)
#pragma unroll
      for (int e = 0; e < 2; ++e) { const int cc = q * 1024 + hd * 64 + 2 * cp + e; mu0[q][e] = mu[cc]; mu1[q][e] = mu[3072 + cc]; }
#pragma unroll
    for (int e = 0; e < 2; ++e) { kkw[e] = p->in[16][(size_t)l * 1024 + hd * 64 + 2 * cp + e]; kaw[e] = p->in[17][(size_t)l * 1024 + hd * 64 + 2 * cp + e]; }
  }
  ScanRegs R;
  auto issue = [&](int chunk) {
#pragma unroll
    for (int i = 0; i < SC_NIT; ++i) { const int s = chunk * SC_CH + 8 * i + 2 * lw + half; int pos, seqlen; const int row = scan_row(s, dir, b, pos, seqlen);
      const int rp = pos > 0 ? row - 1 : row, rn = pos + 1 < seqlen ? row + 1 : row;
#pragma unroll
      for (int q = 0; q < 3; ++q) { const int cc = q * 1024 + hd * 64 + 2 * cp;
        R.rk[i][q * 3 + 0] = *(const unsigned*)(RKV + (size_t)rp * 3072 + cc); R.rk[i][q * 3 + 1] = *(const unsigned*)(RKV + (size_t)row * 3072 + cc); R.rk[i][q * 3 + 2] = *(const unsigned*)(RKV + (size_t)rn * 3072 + cc); }
      R.ev[i] = *(const unsigned*)(EE + (size_t)row * 1024 + hd * 64 + 2 * cp); R.av[i] = *(const unsigned*)(AS + (size_t)row * 1024 + hd * 64 + 2 * cp); }
  };
  auto process = [&](int chunk, float* buf) {
#pragma unroll
    for (int i = 0; i < SC_NIT; ++i) { const int j = 8 * i + 2 * lw + half; const int s = chunk * SC_CH + j; int pos, seqlen; (void)scan_row(s, dir, b, pos, seqlen);
      const float mp = pos > 0 ? 1.f : 0.f, mn = pos + 1 < seqlen ? 1.f : 0.f;
      float x[3][2];
#pragma unroll
      for (int q = 0; q < 3; ++q) {
        x[q][0] = mp * mu0[q][0] * bflo(R.rk[i][q * 3]) + (1.0f - mu0[q][0] - mu1[q][0]) * bflo(R.rk[i][q * 3 + 1]) + mn * mu1[q][0] * bflo(R.rk[i][q * 3 + 2]);
        x[q][1] = mp * mu0[q][1] * bfhi(R.rk[i][q * 3]) + (1.0f - mu0[q][1] - mu1[q][1]) * bfhi(R.rk[i][q * 3 + 1]) + mn * mu1[q][1] * bfhi(R.rk[i][q * 3 + 2]); }
      const float k0 = x[1][0] * kkw[0], k1 = x[1][1] * kkw[1];
      float ss = k0 * k0 + k1 * k1;
      ss = ar16(ss); ss += __shfl_xor(ss, 16);
      const float nr = rsqrtf(ss + 1e-12f);
      const float kn0 = k0 * nr, kn1 = k1 * nr;
      const float e0 = bflo(R.ev[i]), e1 = bfhi(R.ev[i]), a0 = bflo(R.av[i]), a1 = bfhi(R.av[i]);
      float* st = buf + j * SC_STEP_F;
      *(f32x2*)(st + 0 * 64 + 2 * cp) = (f32x2){-kn0, -kn1};
      *(f32x2*)(st + 1 * 64 + 2 * cp) = (f32x2){__expf(-e0), __expf(-e1)};
      *(f32x2*)(st + 2 * 64 + 2 * cp) = (f32x2){kn0 * a0, kn1 * a1};
      *(f32x2*)(st + 3 * 64 + 2 * cp) = (f32x2){x[1][0] * (1.0f + (a0 - 1.0f) * kaw[0]), x[1][1] * (1.0f + (a1 - 1.0f) * kaw[1])};
      *(f32x2*)(st + 4 * 64 + 2 * cp) = (f32x2){x[0][0], x[0][1]};
      if ((cp >> 3) == part) *(f32x2*)(st + 5 * 64 + 2 * (cp & 7)) = (f32x2){x[2][0], x[2][1]};
    }
  };
  auto flush = [&](int chunk, const float* yb) {
    for (int j = lt >> 3; j < SC_CH; j += 32) { const int pr = lt & 7; const int s = chunk * SC_CH + j; int pos, seqlen; const int row = scan_row(s, dir, b, pos, seqlen);
      *(unsigned*)(Y + (size_t)row * 1024 + hd * 64 + 16 * part + 2 * pr) = pk2(yb[j * 16 + 2 * pr], yb[j * 16 + 2 * pr + 1]); }
  };
  __syncthreads();
  if (loader) { issue(0); process(0, bufs); issue(1); }
  __syncthreads();
  f32x4 S = {0.f, 0.f, 0.f, 0.f};
  const int rr = c.lane >> 4, ll = c.lane & 15;
  for (int ch = 0; ch < SC_NCHUNK; ++ch) {
    float* buf = bufs + (ch & 1) * SC_BUF_F;
    if (!loader) {
      float* yb = ybuf + (ch & 1) * (SC_CH * 16);
      const float* st = buf + 4 * ll; const float* vp = buf + 5 * 64 + 4 * c.wave + rr;
      f32x4 na = *(const f32x4*)(st), nw = *(const f32x4*)(st + 64), nb = *(const f32x4*)(st + 128), nk = *(const f32x4*)(st + 192), nr = *(const f32x4*)(st + 256); float nv = vp[0];
#pragma unroll
      for (int jb = 0; jb < SC_CH; jb += 16) {
        float ysel = 0.f;
#pragma unroll
        for (int jj = 0; jj < 16; ++jj) {
          const int j = jb + jj;
          const f32x4 a = na, wv = nw, bv = nb, kd = nk, rv = nr; const float vv = nv;
          if (j + 1 < SC_CH) { const float* sn = st + (j + 1) * SC_STEP_F;
            na = *(const f32x4*)(sn); nw = *(const f32x4*)(sn + 64); nb = *(const f32x4*)(sn + 128); nk = *(const f32x4*)(sn + 192); nr = *(const f32x4*)(sn + 256); nv = vp[(j + 1) * SC_STEP_F]; }
          f32x2 t1 = S.lo * a.lo; t1 = S.hi * a.hi + t1; float sa = t1.x + t1.y;
          sa = ar16(sa);
          S = S * wv + (bv * sa + kd * vv);
          f32x2 t2 = S.lo * rv.lo; t2 = S.hi * rv.hi + t2; float y = t2.x + t2.y;
          y = ar16(y);
          ysel = (ll == jj) ? y : ysel;
        }
        yb[(jb + ll) * 16 + 4 * c.wave + rr] = ysel;
      }
    } else {
      if (ch + 1 < SC_NCHUNK) process(ch + 1, bufs + ((ch + 1) & 1) * SC_BUF_F);
      if (ch + 2 < SC_NCHUNK) issue(ch + 2);
      if (ch > 0) flush(ch - 1, ybuf + ((ch - 1) & 1) * (SC_CH * 16));
    }
    __syncthreads();
  }
  if (loader) flush(SC_NCHUNK - 1, ybuf + ((SC_NCHUNK - 1) & 1) * (SC_CH * 16));
  __syncthreads();
}

#if !defined(NO_GEMM) && (!defined(GEMM_ONLY) || GEMM_ONLY == 0)
#define GEMMCALL0(a,b,c,d) pg8::gemm_phase(a,b,c,d)
#else
#define GEMMCALL0(a,b,c,d) (void)0
#endif
#if !defined(NO_GEMM) && (!defined(GEMM_ONLY) || GEMM_ONLY == 1)
#define GEMMCALL1(a,b,c,d) pg8::gemm_phase(a,b,c,d)
#else
#define GEMMCALL1(a,b,c,d) (void)0
#endif
#if !defined(NO_GEMM) && (!defined(GEMM_ONLY) || GEMM_ONLY == 2)
#define GEMMCALL2(a,b,c,d) pg8::gemm_phase(a,b,c,d)
#else
#define GEMMCALL2(a,b,c,d) (void)0
#endif
#if !defined(NO_GEMM) && (!defined(GEMM_ONLY) || GEMM_ONLY == 3)
#define GEMMCALL3(a,b,c,d) pg8::gemm_phase(a,b,c,d)
#else
#define GEMMCALL3(a,b,c,d) (void)0
#endif
#if !defined(NO_GEMM) && (!defined(GEMM_ONLY) || GEMM_ONLY == 4)
#define GEMMCALL4(a,b,c,d) pg8::gemm_phase(a,b,c,d)
#else
#define GEMMCALL4(a,b,c,d) (void)0
#endif
#if !defined(NO_GEMM) && (!defined(GEMM_ONLY) || GEMM_ONLY == 5)
#define GEMMCALL5(a,b,c,d) pg8::gemm_phase(a,b,c,d)
#else
#define GEMMCALL5(a,b,c,d) (void)0
#endif
#if !defined(NO_GEMM) && (!defined(GEMM_ONLY) || GEMM_ONLY == 6)
#define GEMMCALL6(a,b,c,d) pg8::gemm_phase(a,b,c,d)
#else
#define GEMMCALL6(a,b,c,d) (void)0
#endif
#if !defined(NO_GEMM) && (!defined(GEMM_ONLY) || GEMM_ONLY == 7)
#define GEMMCALL7(a,b,c,d) pg8::gemm_phase(a,b,c,d)
#else
#define GEMMCALL7(a,b,c,d) (void)0
#endif
#if !defined(NO_GEMM) && (!defined(GEMM_ONLY) || GEMM_ONLY == 8)
#define GEMMCALL8(a,b,c,d) pg8::gemm_phase(a,b,c,d)
#else
#define GEMMCALL8(a,b,c,d) (void)0
#endif
#define GSYNC() do { unsigned char* w_ = p0->ws; asm volatile("" : "+s"(w_)); xcd_barrier((unsigned*)(w_ + WS_BAR), (volatile LAS unsigned*)(ldsl + LDS_BAR_OFF)); } while (0)
#ifdef PROBE_ID
#define TSTART(id) do { if (((1u << (id)) & (unsigned)(PROBE_ID)) && blockIdx.x == 0 && threadIdx.x == 0) *(volatile LAS unsigned long long*)(ldsl + LDS_BAR_OFF + 16) -= __builtin_amdgcn_s_memrealtime(); } while (0)
#define TSTOP(id) do { if (((1u << (id)) & (unsigned)(PROBE_ID)) && blockIdx.x == 0 && threadIdx.x == 0) *(volatile LAS unsigned long long*)(ldsl + LDS_BAR_OFF + 16) += __builtin_amdgcn_s_memrealtime(); } while (0)
#else
#define TSTART(id) (void)0
#define TSTOP(id) (void)0
#endif
#define FRESH() do { int t_ = threadIdx.x; asm volatile("" : "+v"(t_)); c.tid = t_; c.lane = t_ & 63; c.wave = __builtin_amdgcn_readfirstlane(t_ >> 6); int b_ = blockIdx.x; asm volatile("" : "+s"(b_)); c.bid = b_; p = p0; asm volatile("" : "+s"(p)); ws = p->ws; } while (0)
#define mod_all ((float*)(ws + WS_MOD))
#define xc ((float*)(ws + WS_XC))
#define H ((bf16_t*)(ws + WS_H))
template <int l>
DI void layer_body(Ctx& c, const PP p0, cg::grid_group& grid, LAS unsigned char* ldsl, unsigned long long& tacc) {
  PP p = p0; unsigned char* ws = p->ws;
  constexpr int MROWS = (l == DEPTH - 1) ? NTL : NTOK;
  TSTART(1);
    const float* xLin = l == 0 ? p->in[0] : p->out; const float* xCin = xc;
    const float* mod = mod_all + (size_t)l * 3 * 6144;
#ifndef NO_SMALL
    TSTART(12); FRESH(); if (l > 0) phase_convert(c, p, l); TSTOP(12);
    FRESH(); phase_norm(c, p, xLin, xc, p->in[6] + (size_t)l * 1024, mod, 0, l == 0 ? 0 : 11);
#endif
    GSYNC();
  TSTOP(1);
  TSTART(2);
    { pg8::Gemm g{H, (const bf16_t*)(ws + WS_WIN), NTOK, 11008, 1024, 1024, 1024, (const bf16_t*)(ws + WS_WV), H, nullptr, nullptr}; FRESH(); pg8::StaticOrder S; S.init(NTOK, 11008, c.nb, c.bid, NTOK / 256); pg8::EpiIn E{ws}; GEMMCALL0(ldsl, g, S, E); }
    GSYNC();
  TSTOP(2);
  TSTART(3);
    { pg8::Gemm g{(const bf16_t*)(ws + WS_LACT), (const bf16_t*)(ws + WS_WLORA), NTOK, 5120, 384, 512, 384, nullptr, nullptr, nullptr, nullptr}; FRESH(); pg8::LoraOrder S; S.S.init(NTOK, 5120, c.nb, c.bid);
      pg8::EpiLora E{ws, p->in[11] + (size_t)l * 2048, p->in[13] + (size_t)l * 2048}; GEMMCALL2(ldsl, g, S, E); }
    GSYNC();
  TSTOP(3);
  TSTART(4);
    { const int nunits = (l == DEPTH - 1) ? 512 : 528;
#ifndef NO_ATTN
      TSTART(13); FRESH(); for (int u = c.bid; u < nunits; u += c.nb) attn_unit(c, p, l, u); TSTOP(13);
#endif
#ifndef NO_CONVA
      TSTART(14); FRESH(); phase_conv_a(c, p, l); TSTOP(14);
#endif
#ifndef NO_SCAN
      FRESH(); phase_scan(c, p, l);
#endif
    }
    GSYNC();
  TSTOP(4);
  TSTART(5);
#ifndef NO_FIN
    FRESH(); phase_rwkv_fin(c, p, l);
#endif
    GSYNC();
  TSTOP(5);
  TSTART(6);
    { pg8::Gemm g{(const bf16_t*)(ws + WS_AB), (const bf16_t*)(ws + WS_WA), NTOK, 1024, 1024, 1024, 1024,
                  (const bf16_t*)(ws + WS_H), (const bf16_t*)(ws + WS_WA + AL((size_t)1024 * 1024 * 2)), (const bf16_t*)(ws + WS_Q), (const bf16_t*)(ws + WS_WA + 2 * AL((size_t)1024 * 1024 * 2))};
      FRESH(); pg8::MergeOrder S; S.S.init(NTL, 1024, c.nb, c.bid); S.nctx = (l == DEPTH - 1) ? 0 : 24; pg8::EpiMergeChain E{ws}; GEMMCALL3(ldsl, g, S, E); }
    if (l < DEPTH - 1) { GSYNC(); FRESH(); phase_mctx(c, p); }
    GSYNC();
  TSTOP(6);
  TSTART(7);
    { const bf16_t* A_ = (const bf16_t*)(ws + WS_YB2); const bf16_t* B_ = (const bf16_t*)(ws + WS_WA + 3 * AL((size_t)1024 * 1024 * 2));
      pg8::Gemm g{A_, B_, NTOK, 1024, 1024, 1024, 1024, A_, B_, nullptr, nullptr}; FRESH(); pg8::ResOrder S; S.S.init(NTL, 1024, c.nb, c.bid); S.ks = 4; S.nktq = 4; S.nsplit = (l == DEPTH - 1) ? 0 : 32;
      pg8::EpiRes E{xLin, xCin, p->out, xc, mod + 2 * 1024, (float*)(ws + WS_CPART), 4}; GEMMCALL6(ldsl, g, S, E); }
    GSYNC();
  TSTOP(7);
  TSTART(8);
    FRESH(); phase_norm(c, p, p->out, xc, p->in[25] + (size_t)l * 1024, mod, 3, l == DEPTH - 1 ? 0 : 4);
    GSYNC();
  TSTOP(8);
  TSTART(9);
    { pg8::Gemm g{H, (const bf16_t*)(ws + WS_WUP), NTOK, 5632, 1024, 1024, 1024, nullptr, nullptr, nullptr, nullptr}; FRESH(); pg8::StaticOrder S; S.init(MROWS, 5632, c.nb, c.bid); pg8::EpiPlain E{(bf16_t*)(ws + WS_U), 5632}; GEMMCALL7(ldsl, g, S, E); }
    GSYNC();
  TSTOP(9);
  TSTART(10);
#ifndef NO_FFNACT
    FRESH(); phase_ffn_act(c, p, l);
#endif
    GSYNC();
  TSTOP(10);
  TSTART(11);
    { const bf16_t* A_ = (const bf16_t*)(ws + WS_GATES); const bf16_t* B_ = (const bf16_t*)(ws + WS_WDN);
      pg8::Gemm g{A_, B_, NTOK, 1024, 2816, 2816, 2816, A_, B_, nullptr, nullptr}; FRESH(); pg8::ResOrder S; S.S.init(NTL, 1024, c.nb, c.bid); S.ks = 11; S.nktq = 4; S.nsplit = (l == DEPTH - 1) ? 0 : 88;
      pg8::EpiRes E{p->out, xc, p->out, xc, mod + 5 * 1024, (float*)(ws + WS_CPART), 4}; GEMMCALL8(ldsl, g, S, E); }
    GSYNC();
  TSTOP(11);
  }

__global__ void __launch_bounds__(NTHR, 2) mega(Params pv) {
  extern __shared__ __attribute__((aligned(16))) unsigned char lds[];
  cg::grid_group grid = cg::this_grid();
  const PP p0 = (PP)__builtin_amdgcn_kernarg_segment_ptr(); PP p = p0;
  Ctx c; c.tid = threadIdx.x; c.lane = c.tid & 63; c.wave = __builtin_amdgcn_readfirstlane(c.tid >> 6); c.bid = blockIdx.x; c.nb = gridDim.x; c.lds = lds;
  LAS unsigned char* ldsl = (LAS unsigned char*)lds;
  unsigned char* ws = p->ws;
  unsigned long long tacc = 0ull;
  if (c.tid < 8) ((volatile LAS unsigned*)(ldsl + LDS_BAR_OFF))[c.tid] = 0u;
  __syncthreads();
  if (c.tid == 0) (void)xb_add(&((unsigned*)(ws + WS_BAR))[XB_XCNT(xb_xcc_id())], 1u);
  TSTART(15);
  FRESH(); phase_mods(c, p);
  TSTOP(15); TSTART(16);
  FRESH(); phase_convert(c, p, 0);
  grid.sync();
  TSTOP(16);
  layer_body<0>(c, p0, grid, ldsl, tacc);
  layer_body<1>(c, p0, grid, ldsl, tacc);
  layer_body<2>(c, p0, grid, ldsl, tacc);
  layer_body<3>(c, p0, grid, ldsl, tacc);
#ifdef PROBE_ID
  if (blockIdx.x == 0 && threadIdx.x == 0) { *(volatile unsigned long long*)(p0->ws + WS_BAR + 15360) = *(volatile LAS unsigned long long*)(ldsl + LDS_BAR_OFF + 16); }
  GSYNC();
  FRESH(); phase_final(c, p, sqrtf((float)(*(volatile unsigned long long*)(p0->ws + WS_BAR + 15360)) * 2e-10f));
#else
  FRESH(); phase_final(c, p, 0.f);
#endif
}

extern "C" void kernel_launch(void* const* d_in, const int* in_sizes, int n_in, void* d_out, int out_size, void* d_ws, size_t ws_size, hipStream_t stream) {
  static int grid = 0;
  if (grid == 0) {
    int dev = 0, cus = 0, per_cu = 0;
    (void)hipGetDevice(&dev); (void)hipDeviceGetAttribute(&cus, hipDeviceAttributeMultiprocessorCount, dev);
    (void)hipFuncSetAttribute((const void*)mega, hipFuncAttributeMaxDynamicSharedMemorySize, LDS_BYTES);
    (void)hipOccupancyMaxActiveBlocksPerMultiprocessor(&per_cu, (const void*)mega, NTHR, LDS_BYTES);
    grid = cus < 256 ? cus : 256;
    if (n_in != 30 || ws_size < WS_END || per_cu < 1) { fprintf(stderr, "kernel_launch: n_in %d ws %zu need %zu per_cu %d\n", n_in, ws_size, (size_t)WS_END, per_cu); if (n_in != 30 || ws_size < WS_END) grid = -1; }
  }
  if (grid < 0) return;
  Params p{};
  for (int i = 0; i < 30; ++i) p.in[i] = (const float*)d_in[i];
  p.out = (float*)d_out; p.ws = (unsigned char*)d_ws;
  (void)hipMemsetAsync((unsigned char*)d_ws + WS_BAR, 0, 32768, stream);
  void* args[] = {&p};
  hipError_t e = hipLaunchCooperativeKernel((const void*)mega, dim3(grid), dim3(NTHR), args, LDS_BYTES, stream);
  if (e != hipSuccess) fprintf(stderr, "cooperative launch failed: %s (grid %d)\n", hipGetErrorString(e), grid);
}
```
